# Optimizing an MI355X kernel written in HIP

```python
import jax, jax.numpy as jnp
from jax import lax
import numpy as np

D_MODEL = 1024
BATCH = 4
SEQ = 4096
DEPTH = 4
DEC_BATCH = 128
DEC_SEQ = 4
PAST_LEN = 2048
PAGE_SIZE = 128

N_A_LAYERS = DEPTH // 2
N_B_LAYERS = DEPTH - N_A_LAYERS
D_RNN = D_MODEL
N_LRU_BLOCKS = 4
LRU_BLOCK = D_RNN // N_LRU_BLOCKS
LRU_C = 8.0
CONV_A_WIDTH = 4
D_FF = 3 * D_MODEL
FFN_CONV_WIDTH = 3
HEAD_DIM = 64
N_KV_HEADS = 8
WINDOWS = (128, 512, 2048)
DILATIONS = (1, 4, 16)
N_GROUPS = len(WINDOWS)
MAX_WINDOW = max(WINDOWS)
BLOCK = 128
ROT_DIM = HEAD_DIM // 4
ROPE_THETA = 500000.0
EPS = 1e-6

kernel_name = 'dual_path_rglru_dilated_swa_step'


def rmsnorm(x, g):
    xf = x.astype(jnp.float32)
    y = xf * lax.rsqrt(jnp.mean(xf * xf, axis=-1, keepdims=True) + EPS)
    return (y * g.astype(jnp.float32)).astype(x.dtype)


def rope(x, pos):
    half = ROT_DIM // 2
    inv = ROPE_THETA ** (-jnp.arange(half, dtype=jnp.float32) * (2.0 / ROT_DIM))
    ang = pos.astype(jnp.float32)[:, None] * inv[None, :]
    shape = (1, pos.shape[0]) + (1,) * (x.ndim - 3) + (half,)
    cos = jnp.cos(ang).reshape(shape)
    sin = jnp.sin(ang).reshape(shape)
    xf = x.astype(jnp.float32)
    x1, x2, rest = xf[..., :half], xf[..., half:ROT_DIM], xf[..., ROT_DIM:]
    out = jnp.concatenate([x1 * cos - x2 * sin, x2 * cos + x1 * sin, rest], axis=-1)
    return out.astype(x.dtype)


def causal_dwconv(prev, x, w, b):
    K = w.shape[0]
    T = x.shape[1]
    xc = jnp.concatenate([prev.astype(x.dtype), x], axis=1)
    y = b + sum(xc[:, j:j + T] * w[j] for j in range(K))
    return y, xc[:, T:]


def _lin_combine(e1, e2):
    a1, b1 = e1
    a2, b2 = e2
    return a1 * a2, a2 * b1 + b2


def recurrent_block(h, conv_prev, h0, w_in, conv_w, conv_b, r_w, r_b, i_w, i_b, lam, w_out):
    B, T, _ = h.shape
    gate, xb = jnp.split(h @ w_in, 2, axis=-1)
    xc, conv_state = causal_dwconv(conv_prev, xb, conv_w, conv_b)
    xf = xc.astype(jnp.float32)
    xblk = xf.reshape(B, T, N_LRU_BLOCKS, LRU_BLOCK)
    r = jax.nn.sigmoid(jnp.einsum('btnc,ncd->btnd', xblk, r_w.astype(jnp.float32)) + r_b.astype(jnp.float32)).reshape(B, T, D_RNN)
    i = jax.nn.sigmoid(jnp.einsum('btnc,ncd->btnd', xblk, i_w.astype(jnp.float32)) + i_b.astype(jnp.float32)).reshape(B, T, D_RNN)
    log_a = -LRU_C * r * jax.nn.softplus(-lam.astype(jnp.float32))
    a = jnp.exp(log_a)
    u = jnp.sqrt(-jnp.expm1(2.0 * log_a)) * (i * xf)
    a_cum, u_cum = lax.associative_scan(_lin_combine, (a, u), axis=1)
    hs = a_cum * h0.astype(jnp.float32)[:, None] + u_cum
    y = hs.astype(h.dtype) * jax.nn.gelu(gate)
    return y @ w_out, conv_state, hs[:, -1].astype(h.dtype)


def conv_ffn(h, prev, w_up, conv_w, conv_b, w_down):
    g, v = jnp.split(h @ w_up, 2, axis=-1)
    gc, new_prev = causal_dwconv(prev, g, conv_w, conv_b)
    return (jax.nn.gelu(gc) * v) @ w_down, new_prev


def shared_kv(x, pos, g_kv, w_kv, g_k):
    B, T, _ = x.shape
    kv = (rmsnorm(x, g_kv) @ w_kv).reshape(B, T, 2, N_KV_HEADS, HEAD_DIM)
    k = rope(rmsnorm(kv[:, :, 0], g_k), pos)
    return k, kv[:, :, 1]


def queries(h, pos, w_q, g_q):
    B, T, _ = h.shape
    q = (h @ w_q).reshape(B, T, N_GROUPS, N_KV_HEADS, HEAD_DIM)
    return rope(rmsnorm(q, g_q), pos)


def dilated_band_attn(q, k, v, dilation, span):
    B, T, H, E = q.shape
    L = T // dilation
    nb = -(-L // BLOCK)
    Lp = nb * BLOCK

    def to_res(t):
        t = jnp.moveaxis(t.reshape(B, L, dilation, H, E), 2, 1)
        t = jnp.pad(t, ((0, 0), (0, 0), (0, Lp - L), (0, 0), (0, 0)))
        return t.reshape(B, dilation, nb, BLOCK, H, E)

    def with_prev(t):
        prev = jnp.pad(t, ((0, 0), (0, 0), (1, 0), (0, 0), (0, 0), (0, 0)))[:, :, :-1]
        return jnp.concatenate([prev, t], axis=3)

    qb = to_res(q)
    kk = with_prev(to_res(k))
    vv = with_prev(to_res(v))
    s = jnp.einsum('bdnqhe,bdnkhe->bdnhqk', qb, kk, preferred_element_type=jnp.float32) * (HEAD_DIM ** -0.5)
    qi = jnp.arange(BLOCK)[:, None]
    ki = jnp.arange(2 * BLOCK)[None, :]
    dist = BLOCK + qi - ki
    mq = jnp.arange(nb)[:, None, None] * BLOCK + qi
    valid = (dist >= 0) & (dist <= span) & (mq - dist >= 0)
    s = jnp.where(valid[:, None], s, -jnp.inf)
    m = jnp.max(s, axis=-1, keepdims=True)
    p = jnp.exp(s - m)
    den = jnp.sum(p, axis=-1)
    o = jnp.einsum('bdnhqk,bdnkhe->bdnqhe', p, vv, preferred_element_type=jnp.float32)
    o = o / jnp.swapaxes(den, -1, -2)[..., None]
    lse = jnp.swapaxes(m[..., 0] + jnp.log(den), -1, -2)

    def back(t):
        t = t.reshape((B, dilation, Lp) + t.shape[4:])[:, :, :L]
        return jnp.moveaxis(t, 1, 2).reshape((B, T) + t.shape[3:])

    return back(o), back(lse)


def dilated_gather_attn(q, k_all, v_all, n_past, dilation, span):
    S = q.shape[1]
    idx = n_past + jnp.arange(S)[:, None] - dilation * jnp.arange(span + 1)[None, :]
    valid = idx >= 0
    idxc = jnp.maximum(idx, 0)
    kg = k_all[:, idxc]
    vg = v_all[:, idxc]
    s = jnp.einsum('bshe,bsjhe->bshj', q, kg, preferred_element_type=jnp.float32) * (HEAD_DIM ** -0.5)
    s = jnp.where(valid[:, None, :], s, -jnp.inf)
    m = jnp.max(s, axis=-1, keepdims=True)
    p = jnp.exp(s - m)
    den = jnp.sum(p, axis=-1)
    o = jnp.einsum('bshj,bsjhe->bshe', p, vg, preferred_element_type=jnp.float32) / den[..., None]
    return o, m[..., 0] + jnp.log(den)


def combine_groups(outs, lses, dtype):
    w = jax.nn.softmax(jnp.stack(lses), axis=0)
    o = jnp.sum(w[..., None] * jnp.stack(outs), axis=0)
    B, T, H, E = o.shape
    return o.reshape(B, T, H * E).astype(dtype)


def mixture_prompt(q, k, v):
    outs, lses = [], []
    for g in range(N_GROUPS):
        o, l = dilated_band_attn(q[:, :, g], k, v, DILATIONS[g], WINDOWS[g] // DILATIONS[g])
        outs.append(o)
        lses.append(l)
    return combine_groups(outs, lses, q.dtype)


def mixture_sample(q, k_all, v_all, n_past):
    outs, lses = [], []
    for g in range(N_GROUPS):
        o, l = dilated_gather_attn(q[:, :, g], k_all, v_all, n_past, DILATIONS[g], WINDOWS[g] // DILATIONS[g])
        outs.append(o)
        lses.append(l)
    return combine_groups(outs, lses, q.dtype)


def trunk(x, pos, conv_a_prev, h0, ffn_prev, extend_kv, attend, p):
    hs_new, conv_new, ffn_new = [], [], []
    k = v = k_att = v_att = None
    for layer in range(DEPTH):
        if layer < N_A_LAYERS:
            out, cs, hl = recurrent_block(
                rmsnorm(x, p['norm_mix_a'][layer]), conv_a_prev[layer], h0[layer],
                p['w_in_a'][layer], p['conv_a_w'][layer], p['conv_a_b'][layer],
                p['gate_r_w'][layer], p['gate_r_b'][layer], p['gate_i_w'][layer], p['gate_i_b'][layer],
                p['lru_lambda'][layer], p['w_out_a'][layer])
            conv_new.append(cs)
            hs_new.append(hl)
        else:
            j = layer - N_A_LAYERS
            q = queries(rmsnorm(x, p['norm_mix_b'][j]), pos, p['w_q'][j], p['q_norm'][j])
            out = attend(q, k_att, v_att) @ p['w_o'][j]
        x = x + out
        f, fs = conv_ffn(rmsnorm(x, p['norm_ffn'][layer]), ffn_prev[layer], p['w_ffn_up'][layer],
                         p['ffn_conv_w'][layer], p['ffn_conv_b'][layer], p['w_ffn_down'][layer])
        ffn_new.append(fs)
        x = x + f
        if layer == N_A_LAYERS - 1:
            k, v = shared_kv(x, pos, p['norm_kv'], p['w_kv'], p['k_norm'])
            k_att, v_att = extend_kv(k, v)
    return x, k, v, jnp.stack(hs_new), jnp.stack(conv_new), jnp.stack(ffn_new)


def setup_inputs(seed: int = 0) -> dict:
    key = jax.random.key(seed)
    ks = iter(jax.random.split(key, 32))

    def nrm(shape, scale):
        return scale * jax.random.normal(next(ks), shape, jnp.float32)

    w_buf = min(MAX_WINDOW, PAST_LEN)
    a0 = None
    d = {}
    d['x_prompt'] = nrm((BATCH, SEQ, D_MODEL), 1.0)
    d['x_sample'] = nrm((DEC_BATCH, DEC_SEQ, D_MODEL), 1.0)
    d['cache_k'] = nrm((DEC_BATCH, w_buf, N_KV_HEADS, HEAD_DIM), 1.0)
    d['cache_v'] = nrm((DEC_BATCH, w_buf, N_KV_HEADS, HEAD_DIM), 1.0)
    d['state_rglru_h'] = nrm((N_A_LAYERS, DEC_BATCH, D_RNN), 0.5)
    d['state_rglru_conv'] = nrm((N_A_LAYERS, DEC_BATCH, CONV_A_WIDTH - 1, D_RNN), 1.0)
    d['state_ffn_conv'] = nrm((DEPTH, DEC_BATCH, FFN_CONV_WIDTH - 1, D_FF), 1.0)
    d['norm_mix_a'] = 1.0 + nrm((N_A_LAYERS, D_MODEL), 0.1)
    d['w_in_a'] = nrm((N_A_LAYERS, D_MODEL, 2 * D_RNN), D_MODEL ** -0.5)
    d['conv_a_w'] = nrm((N_A_LAYERS, CONV_A_WIDTH, D_RNN), CONV_A_WIDTH ** -0.5)
    d['conv_a_b'] = nrm((N_A_LAYERS, D_RNN), 0.01)
    d['gate_r_w'] = nrm((N_A_LAYERS, N_LRU_BLOCKS, LRU_BLOCK, LRU_BLOCK), LRU_BLOCK ** -0.5)
    d['gate_r_b'] = nrm((N_A_LAYERS, N_LRU_BLOCKS, LRU_BLOCK), 0.01)
    d['gate_i_w'] = nrm((N_A_LAYERS, N_LRU_BLOCKS, LRU_BLOCK, LRU_BLOCK), LRU_BLOCK ** -0.5)
    d['gate_i_b'] = nrm((N_A_LAYERS, N_LRU_BLOCKS, LRU_BLOCK), 0.01)
    a0 = jax.random.uniform(next(ks), (N_A_LAYERS, D_RNN), jnp.float32, minval=0.9, maxval=0.999)
    d['lru_lambda'] = jnp.log(a0) - jnp.log1p(-a0)
    d['w_out_a'] = nrm((N_A_LAYERS, D_RNN, D_MODEL), D_RNN ** -0.5)
    d['norm_kv'] = 1.0 + nrm((D_MODEL,), 0.1)
    d['w_kv'] = nrm((D_MODEL, 2 * N_KV_HEADS * HEAD_DIM), D_MODEL ** -0.5)
    d['k_norm'] = 1.0 + nrm((HEAD_DIM,), 0.1)
    d['norm_mix_b'] = 1.0 + nrm((N_B_LAYERS, D_MODEL), 0.1)
    d['w_q'] = nrm((N_B_LAYERS, D_MODEL, N_GROUPS * N_KV_HEADS * HEAD_DIM), D_MODEL ** -0.5)
    d['q_norm'] = 1.0 + nrm((N_B_LAYERS, HEAD_DIM), 0.1)
    d['w_o'] = nrm((N_B_LAYERS, N_KV_HEADS * HEAD_DIM, D_MODEL), (N_KV_HEADS * HEAD_DIM) ** -0.5)
    d['norm_ffn'] = 1.0 + nrm((DEPTH, D_MODEL), 0.1)
    d['w_ffn_up'] = nrm((DEPTH, D_MODEL, 2 * D_FF), D_MODEL ** -0.5)
    d['ffn_conv_w'] = nrm((DEPTH, FFN_CONV_WIDTH, D_FF), FFN_CONV_WIDTH ** -0.5)
    d['ffn_conv_b'] = nrm((DEPTH, D_FF), 0.01)
    d['w_ffn_down'] = nrm((DEPTH, D_FF, D_MODEL), D_FF ** -0.5)
    return d


def reference(x_prompt, x_sample, cache_k, cache_v, state_rglru_h, state_rglru_conv, state_ffn_conv,
              norm_mix_a, w_in_a, conv_a_w, conv_a_b, gate_r_w, gate_r_b, gate_i_w, gate_i_b,
              lru_lambda, w_out_a, norm_kv, w_kv, k_norm, norm_mix_b, w_q, q_norm, w_o,
              norm_ffn, w_ffn_up, ffn_conv_w, ffn_conv_b, w_ffn_down):
    p = dict(norm_mix_a=norm_mix_a, w_in_a=w_in_a, conv_a_w=conv_a_w, conv_a_b=conv_a_b,
             gate_r_w=gate_r_w, gate_r_b=gate_r_b, gate_i_w=gate_i_w, gate_i_b=gate_i_b,
             lru_lambda=lru_lambda, w_out_a=w_out_a, norm_kv=norm_kv, w_kv=w_kv, k_norm=k_norm,
             norm_mix_b=norm_mix_b, w_q=w_q, q_norm=q_norm, w_o=w_o, norm_ffn=norm_ffn,
             w_ffn_up=w_ffn_up, ffn_conv_w=ffn_conv_w, ffn_conv_b=ffn_conv_b, w_ffn_down=w_ffn_down)

    bp, tp, _ = x_prompt.shape
    dt = x_prompt.dtype
    pos_p = jnp.arange(tp)
    y_prompt, k_p, v_p, p_h, p_conv, p_ffn = trunk(
        x_prompt, pos_p,
        jnp.zeros((N_A_LAYERS, bp, CONV_A_WIDTH - 1, D_RNN), dt),
        jnp.zeros((N_A_LAYERS, bp, D_RNN), jnp.float32),
        jnp.zeros((DEPTH, bp, FFN_CONV_WIDTH - 1, D_FF), dt),
        lambda k, v: (k, v),
        mixture_prompt, p)
    keep = min(MAX_WINDOW, tp)
    p_cache_k = k_p[:, tp - keep:]
    p_cache_v = v_p[:, tp - keep:]

    n_past = cache_k.shape[1]
    pos_s = PAST_LEN + jnp.arange(x_sample.shape[1])
    y_sample, s_cache_k, s_cache_v, s_h, s_conv, s_ffn = trunk(
        x_sample, pos_s, state_rglru_conv, state_rglru_h, state_ffn_conv,
        lambda k, v: (jnp.concatenate([cache_k.astype(k.dtype), k], axis=1),
                      jnp.concatenate([cache_v.astype(v.dtype), v], axis=1)),
        lambda q, ka, va: mixture_sample(q, ka, va, n_past), p)

    return (y_prompt, y_sample, p_h, p_conv, p_ffn, p_cache_k, p_cache_v,
            s_h, s_conv, s_ffn, s_cache_k, s_cache_v)
```

```cpp
#include <hip/hip_runtime.h>
#include <cstdio>
#include <cstdint>

#define LAS __attribute__((address_space(3)))
#define GAS __attribute__((address_space(1)))
typedef _Float16 f16;
typedef _Float16 h8 __attribute__((ext_vector_type(8)));
typedef _Float16 h4 __attribute__((ext_vector_type(4)));
typedef _Float16 h2 __attribute__((ext_vector_type(2)));
typedef float f32x4 __attribute__((ext_vector_type(4)));
typedef float f32x2 __attribute__((ext_vector_type(2)));
typedef unsigned u32x4 __attribute__((ext_vector_type(4)));
typedef unsigned u32x2 __attribute__((ext_vector_type(2)));
typedef short s16x4 __attribute__((ext_vector_type(4)));

constexpr int D = 1024, SEQ = 4096, BP = 4, MP = BP * SEQ, BS = 128, TS = 4, MS = BS * TS, M = MP + MS;
constexpr int DFF = 3072, NH = 8, HD = 64, NG = 3, DKV = NH * HD, NPAST = 2048;
constexpr float EPS = 1e-6f;

constexpr size_t O_YP = 0, O_YS = 16777216, O_PH = 17301504, O_PCONV = 17309696, O_PFFN = 17334272, O_PCK = 17432576, O_PCV = 21626880,
                 O_SH = 25821184, O_SCONV = 26083328, O_SFFN = 26869760, O_SCK = 30015488, O_SCV = 30277632;

constexpr size_t MiB = 1u << 20;
constexpr size_t WS_CTL = 0, CTL_ZERO_BYTES = 1 * MiB;
constexpr size_t WS_WIN = 2 * MiB;
constexpr size_t WS_WG = WS_WIN + 8 * MiB;
constexpr size_t WS_WOUT = WS_WG + 2 * MiB;
constexpr size_t WS_WKVQ = WS_WOUT + 4 * MiB;
constexpr size_t WS_WQ1 = WS_WKVQ + 5 * MiB;
constexpr size_t WS_WO = WS_WQ1 + 3 * MiB;
constexpr size_t WS_WUP = WS_WO + 2 * MiB;
constexpr size_t WS_WDN = WS_WUP + 48 * MiB;
constexpr size_t WS_XRES = WS_WDN + 24 * MiB;
constexpr size_t WS_XH = WS_XRES + 66 * MiB;
constexpr size_t WS_SS = WS_XH + 33 * MiB;
constexpr size_t WS_GG = WS_SS + 2 * MiB;
constexpr size_t WS_XB = WS_GG + 33 * MiB;
constexpr size_t WS_XC = WS_XB + 33 * MiB;
constexpr size_t WS_Y = WS_XC + 33 * MiB;
constexpr size_t WS_LA = WS_Y + 33 * MiB;
constexpr size_t WS_IX = WS_LA + 66 * MiB;
constexpr size_t WS_G = WS_IX + 66 * MiB;
constexpr size_t WS_V = WS_G + 99 * MiB;
constexpr size_t WS_MID = WS_V + 99 * MiB;
constexpr size_t WS_RAW = WS_MID + 99 * MiB;
constexpr size_t WS_KH = WS_RAW + 165 * MiB;
constexpr size_t WS_VH = WS_KH + 17 * MiB;
constexpr size_t WS_QH = WS_VH + 17 * MiB;
constexpr size_t WS_OG = WS_QH + 50 * MiB;
constexpr size_t WS_LSE = WS_OG + 50 * MiB;
constexpr size_t WS_ATT = WS_LSE + 2 * MiB;
constexpr size_t WS_CA = WS_ATT + 17 * MiB;
constexpr size_t WS_CH = WS_CA + 1 * MiB;
constexpr size_t WS_SPL = WS_CH + 1 * MiB;
constexpr size_t WS_END = WS_SPL + 1 * MiB;

constexpr int CW_BAR = 4096;
constexpr int NWAVES = 8;
constexpr int RING_BYTES = 131072, LDSCTL_OFF = RING_BYTES, MISC_OFF = LDSCTL_OFF + 320, LDS_BYTES = 147456;

namespace pg8 {
constexpr int BM = 256, BK = 64, HALF = 128, HTB = HALF * BK * 2, STAGE_BYTES = 8 * HTB, NXCD = 8, WGM = 8;
__host__ __device__ __forceinline__ int lds_byte(int r, int c) { const int st = (r >> 4) * 2 + (c >> 5), rr = r & 15, cc = c & 31, ob = rr * 64 + cc * 2; return st * 1024 + (ob ^ (((ob >> 9) & 1) << 5)); }
__host__ __device__ __forceinline__ void stage_rc(int b, int& R, int& C) { const int st = b / 1024, sb = b % 1024, swz = sb ^ (((sb >> 9) & 1) << 5); R = (st >> 1) * 16 + swz / 64; C = (st & 1) * 32 + (swz % 64) / 2; }
struct Unit { int pm, pn; };
struct Gemm { const f16* A; const f16* Bt; int lda, ldb, M, N, K, a_pn_bytes; };
struct StaticOrder {
    int nM, nN, nwg, G, c;
    __device__ void init(int M_, int N_, int G_, int c_) { nM = M_ / BM; nN = N_ / BM; nwg = nM * nN; G = G_; c = c_; }
    __device__ bool next(int i, Unit& u) const {
        const long L = (long)i * G + c; if (L >= nwg) return false;
        int wgid = (int)L; { const int q = nwg / NXCD, r = nwg % NXCD, xcd = wgid % NXCD, off = wgid / NXCD; wgid = (xcd < r ? xcd * (q + 1) : r * (q + 1) + (xcd - r) * q) + off; }
        const int nig = WGM * nN, gid = wgid / nig, fm = gid * WGM, gsz = (nM - fm) < WGM ? (nM - fm) : WGM;
        u.pm = fm + ((wgid % nig) % gsz); u.pn = (wgid % nig) / gsz; return true;
    }
};
template <class Epi>
__device__ __forceinline__ void gemm_phase(LAS unsigned char* lds, const Gemm g, const StaticOrder& S, const Epi& E) {
    int tid_ = threadIdx.x; asm volatile("" : "+v"(tid_));
    const int tid = tid_, wid = __builtin_amdgcn_readfirstlane(tid >> 6), lane = tid & 63, wr = wid >> 2, wc = wid & 3, fr = lane & 15, fq = lane >> 4;
    const int K = g.K, nt = K / BK;
    unsigned voffA[2], voffB[2];
#pragma unroll
    for (int i = 0; i < 2; ++i) { int R, C; stage_rc(tid * 16 + i * 8192, R, C); voffA[i] = (unsigned)(R * g.lda + C) * 2u; voffB[i] = (unsigned)(R * g.ldb + C) * 2u; }
    const size_t kstep = (size_t)(BK * 2);
    const size_t hstepA = (size_t)HALF * g.lda * 2, hstepB = (size_t)HALF * g.ldb * 2;
    const size_t tstepA = 2 * hstepA, tstepB = 2 * hstepB;
    const unsigned ldsw = (unsigned)wid * 1024u;
    const int aoff = lds_byte(wr * 64 + fr, fq * 8), boff = lds_byte(wc * 32 + fr, fq * 8);
#define PG8_SA(b, h) (((b) * 2 + (h)) * HTB)
#define PG8_SB(b, h) ((4 + (b) * 2 + (h)) * HTB)
#define PG8_STAGE(bufoff, gbase, voff) do { _Pragma("unroll") for (int _i = 0; _i < 2; ++_i) \
        __builtin_amdgcn_global_load_lds((const unsigned*)((const char*)(gbase) + (voff)[_i]), (LAS unsigned*)(lds + (bufoff) + ldsw + _i * 8192), 16, 0, 0); } while (0)
#define PG8_LDA(dst, b, h) do { _Pragma("unroll") for (int m = 0; m < 4; ++m) _Pragma("unroll") for (int k = 0; k < 2; ++k) dst[m][k] = *(const LAS h8*)(lds + PG8_SA(b, h) + aoff + m * 2048 + k * 1024); } while (0)
#define PG8_LDB(dst, b, h) do { _Pragma("unroll") for (int n = 0; n < 2; ++n) _Pragma("unroll") for (int k = 0; k < 2; ++k) dst[n][k] = *(const LAS h8*)(lds + PG8_SB(b, h) + boff + n * 2048 + k * 1024); } while (0)
#define PG8_MMA(ai, bj, At, Bt) do { __builtin_amdgcn_s_setprio(1); _Pragma("unroll") for (int m = 0; m < 4; ++m) _Pragma("unroll") for (int n = 0; n < 2; ++n) _Pragma("unroll") for (int k = 0; k < 2; ++k) \
        acc[ai][bj][m][n] = __builtin_amdgcn_mfma_f32_16x16x32_f16(Bt[n][k], At[m][k], acc[ai][bj][m][n], 0, 0, 0); __builtin_amdgcn_s_setprio(0); } while (0)
#define PG8_WAIT_V(n) asm volatile("s_waitcnt vmcnt(" #n ")" ::: "memory")
#define PG8_WAIT_L(n) asm volatile("s_waitcnt lgkmcnt(" #n ")" ::: "memory")
#define PG8_BAR __builtin_amdgcn_s_barrier()
#define PG8_SCHED __builtin_amdgcn_sched_barrier(0)
    Unit cur, nxt; int ui = 0;
    if (!S.next(0, cur)) return;
    f32x4 acc[2][2][4][2];
#pragma unroll
    for (int a = 0; a < 2; ++a)
#pragma unroll
        for (int b = 0; b < 2; ++b)
#pragma unroll
            for (int m = 0; m < 4; ++m)
#pragma unroll
                for (int n = 0; n < 2; ++n) acc[a][b][m][n] = (f32x4){0.f, 0.f, 0.f, 0.f};
    h8 At[4][2], B0[2][2], B1[2][2];
    const char* cA = (const char*)g.A + (size_t)cur.pm * tstepA + (size_t)(cur.pn >> 1) * g.a_pn_bytes; const char* cB = (const char*)g.Bt + (size_t)cur.pn * tstepB;
    PG8_STAGE(PG8_SB(0, 0), cB, voffB); PG8_STAGE(PG8_SB(0, 1), cB + hstepB, voffB); PG8_STAGE(PG8_SA(0, 0), cA, voffA); PG8_STAGE(PG8_SA(0, 1), cA + hstepA, voffA);
    if (wr == 1) PG8_BAR;
    PG8_WAIT_V(2); PG8_BAR;
    PG8_STAGE(PG8_SB(1, 0), cB + kstep, voffB); PG8_STAGE(PG8_SA(1, 0), cA + kstep, voffA); PG8_STAGE(PG8_SB(1, 1), cB + hstepB + kstep, voffB);
    PG8_WAIT_V(6); PG8_BAR;
    for (;;) {
        const bool has_next = S.next(ui + 1, nxt);
        const char* nA = has_next ? (const char*)g.A + (size_t)nxt.pm * tstepA + (size_t)(nxt.pn >> 1) * g.a_pn_bytes : cA; const char* nB = has_next ? (const char*)g.Bt + (size_t)nxt.pn * tstepB : cB;
#pragma unroll 1
        for (int t = 0; t < nt; t += 2) {
            const bool last = (t == nt - 2);
            const char* a1 = cA + (size_t)(t + 1) * kstep;
            const char* a2 = last ? nA : cA + (size_t)(t + 2) * kstep; const char* b2 = last ? nB : cB + (size_t)(t + 2) * kstep;
            const char* a3 = a2 + kstep; const char* b3 = b2 + kstep;
            PG8_LDB(B0, 0, 0); PG8_LDB(B1, 0, 1); PG8_SCHED; PG8_LDA(At, 0, 0); PG8_STAGE(PG8_SA(1, 1), a1 + hstepA, voffA);
            PG8_WAIT_V(8); PG8_WAIT_L(0); PG8_BAR; PG8_MMA(0, 0, At, B0); PG8_MMA(0, 1, At, B1); PG8_BAR; PG8_SCHED;
            PG8_LDA(At, 0, 1); PG8_STAGE(PG8_SB(0, 0), b2, voffB); PG8_STAGE(PG8_SB(0, 1), b2 + hstepB, voffB); PG8_STAGE(PG8_SA(0, 0), a2, voffA);
            PG8_WAIT_V(8); PG8_WAIT_L(0); PG8_BAR; PG8_MMA(1, 0, At, B0); PG8_MMA(1, 1, At, B1); PG8_BAR; PG8_SCHED;
            PG8_LDB(B0, 1, 0); PG8_LDB(B1, 1, 1); PG8_SCHED; PG8_LDA(At, 1, 0); PG8_STAGE(PG8_SA(0, 1), a2 + hstepA, voffA);
            PG8_WAIT_V(8); PG8_WAIT_L(0); PG8_BAR; PG8_MMA(0, 0, At, B0); PG8_MMA(0, 1, At, B1); PG8_BAR; PG8_SCHED;
            PG8_LDA(At, 1, 1); PG8_STAGE(PG8_SB(1, 0), b3, voffB); PG8_STAGE(PG8_SB(1, 1), b3 + hstepB, voffB); PG8_STAGE(PG8_SA(1, 0), a3, voffA);
            PG8_WAIT_V(8); PG8_WAIT_L(0); PG8_BAR; PG8_MMA(1, 0, At, B0); PG8_MMA(1, 1, At, B1); PG8_BAR; PG8_SCHED;
        }
        if (wr == 0) PG8_BAR;
        E(acc, cur, wr, wc, fr, fq);
        if (!has_next) break;
#pragma unroll
        for (int a = 0; a < 2; ++a)
#pragma unroll
            for (int b = 0; b < 2; ++b)
#pragma unroll
                for (int m = 0; m < 4; ++m)
#pragma unroll
                    for (int n = 0; n < 2; ++n) acc[a][b][m][n] = (f32x4){0.f, 0.f, 0.f, 0.f};
        cur = nxt; cA = nA; cB = nB; ++ui;
        if (wr == 1) PG8_BAR;
    }
    PG8_WAIT_V(0);
    PG8_BAR;
#undef PG8_SA
#undef PG8_SB
#undef PG8_STAGE
#undef PG8_LDA
#undef PG8_LDB
#undef PG8_MMA
#undef PG8_WAIT_V
#undef PG8_WAIT_L
#undef PG8_BAR
#undef PG8_SCHED
}
}

#define LDS_WAIT() asm volatile("s_waitcnt lgkmcnt(0)" ::: "memory")
#define VM_WAIT() asm volatile("s_waitcnt vmcnt(0)" ::: "memory")
__device__ __forceinline__ h4 cvt_h4(f32x4 v) { const h2 a = __builtin_convertvector((f32x2){v.x, v.y}, h2), b = __builtin_convertvector((f32x2){v.z, v.w}, h2); return (h4){a.x, a.y, b.x, b.y}; }
__device__ __forceinline__ f32x4 cvt_f4(h4 v) { return (f32x4){(float)v.x, (float)v.y, (float)v.z, (float)v.w}; }
__device__ __forceinline__ float rcpf(float x) { return __builtin_amdgcn_rcpf(x); }
__device__ __forceinline__ float sigmoidf_(float z) { return rcpf(1.0f + __expf(-z)); }
__device__ __forceinline__ float gelu_tanh(float x) { const float z = 0.7978845608028654f * (x + 0.044715f * x * x * x); return x * rcpf(1.0f + __expf(-2.0f * z)); }
__device__ __forceinline__ int opq_tid() { int t = threadIdx.x; asm volatile("" : "+v"(t)); return t; }
__device__ __forceinline__ float wave_sum(float v) {
#pragma unroll
    for (int o = 1; o < 64; o <<= 1) v += __shfl_xor(v, o);
    return v;
}

#define XB_TMO      128
#define XB_XCNT(j)  (256  + 64 * (j))
#define XB_XSUB(j)  (1280 + 64 * (j))
#define XB_XGEN(j)  (2304 + 64 * (j))
#define XB_TOP      3328
#define XB_TOPGEN   3392
#define XCD_BAR_WORDS 3456
#define XB_SPIN_CAP (1u << 18)
__device__ __forceinline__ unsigned xb_ld(unsigned* p)              { return __hip_atomic_load(p, __ATOMIC_RELAXED, __HIP_MEMORY_SCOPE_AGENT); }
__device__ __forceinline__ unsigned xb_add(unsigned* p, unsigned v) { return __hip_atomic_fetch_add(p, v, __ATOMIC_RELAXED, __HIP_MEMORY_SCOPE_AGENT); }
__device__ __forceinline__ unsigned xb_xcc_id() { return (unsigned)__builtin_amdgcn_s_getreg((3 << 11) | 20) & 0xFu; }
#define XB_SPIN(cond, bar) do { unsigned _sp = 0; while (cond) { __builtin_amdgcn_s_sleep(1); \
    if ((++_sp & 255u) == 0u) { if (xb_ld(&(bar)[XB_TMO])) break; if (_sp > XB_SPIN_CAP) { atomicAdd(&(bar)[XB_TMO], 1u); break; } } } } while (0)
struct XcdBarrier { unsigned* bar; unsigned x; volatile LAS unsigned* st; };
__device__ __forceinline__ XcdBarrier xcd_barrier_post(unsigned* bar, volatile LAS unsigned* st) {
    XcdBarrier b; b.bar = bar; b.x = xb_xcc_id(); b.st = st;
    if (threadIdx.x == 0) (void)xb_add(&bar[XB_XCNT(b.x)], 1u);
    return b;
}
__device__ __forceinline__ void xcd_barrier_complete(unsigned* bar, unsigned x, unsigned& nloc, unsigned& nx) {
    const unsigned G = gridDim.x * gridDim.y * gridDim.z;
    unsigned sum, cnt, mine, sp = 0u;
    for (;;) {
        sum = 0u; cnt = 0u; mine = 0u;
#pragma unroll
        for (unsigned j = 0; j < 16; ++j) { const unsigned c = xb_ld(&bar[XB_XCNT(j)]); sum += c; cnt += (c > 0u) ? 1u : 0u; mine = (j == x) ? c : mine; }
        if (sum == G) break;
        __builtin_amdgcn_s_sleep(1);
        if ((++sp & 255u) == 0u) { if (xb_ld(&bar[XB_TMO])) break; if (sp > XB_SPIN_CAP) { atomicAdd(&bar[XB_TMO], 1u); break; } }
    }
    nloc = mine > 0u ? mine : 1u; nx = cnt > 0u ? cnt : 1u;
}
__device__ __forceinline__ void xcd_barrier(const XcdBarrier& b) {
    asm volatile("s_waitcnt vmcnt(0)" ::: "memory");
    __syncthreads();
    if (threadIdx.x == 0) {
        unsigned* bar = b.bar;
        __builtin_amdgcn_s_waitcnt(0);
        unsigned nloc = b.st[0], nx = b.st[1];
        if (nloc == 0u) { xcd_barrier_complete(bar, b.x, nloc, nx); b.st[0] = nloc; b.st[1] = nx; }
        const unsigned old = xb_add(&bar[XB_XSUB(b.x)], 1u);
        const unsigned gen = old / nloc;
        if (old + 1u == (gen + 1u) * nloc) {
            __builtin_amdgcn_fence(__ATOMIC_RELEASE, "agent");
            asm volatile("s_waitcnt vmcnt(0)" ::: "memory");
            const unsigned og = xb_add(&bar[XB_TOP], 1u);
            const unsigned tg = og / nx;
            if (og + 1u == (tg + 1u) * nx) xb_add(&bar[XB_TOPGEN], 1u);
            else XB_SPIN(xb_ld(&bar[XB_TOPGEN]) == tg, bar);
            __builtin_amdgcn_fence(__ATOMIC_ACQUIRE, "agent");
            xb_add(&bar[XB_XGEN(b.x)], 1u);
            asm volatile("s_waitcnt vmcnt(0)" ::: "memory");
        } else {
            XB_SPIN(xb_ld(&bar[XB_XGEN(b.x)]) == gen, bar);
            __builtin_amdgcn_fence(__ATOMIC_ACQUIRE, "agent");
            asm volatile("s_waitcnt vmcnt(0)" ::: "memory");
        }
    }
    __syncthreads();
}

struct Args { const float* in[29]; float* out; unsigned char* ws; int ph_lo, ph_hi; };
struct Ctx {
    LAS unsigned char* lds;
    int G, bid;
    const float* const* in; float* out; unsigned char* ws;
};
#define WSP(T, off) ((T*)(C.ws + (off)))

__device__ __forceinline__ void row_bt(int row, bool& smp, int& b, int& t) { smp = row >= MP; if (!smp) { b = row >> 12; t = row & (SEQ - 1); } else { const int r = row - MP; b = r >> 2; t = r & 3; } }
__device__ __forceinline__ float row_rinv(const float* ss, int row) {
    const f32x4* p = (const f32x4*)(ss + (size_t)row * 16); const f32x4 a = p[0], b = p[1], c = p[2], d = p[3];
    const float s = ((a.x + a.y) + (a.z + a.w)) + ((b.x + b.y) + (b.z + b.w)) + ((c.x + c.y) + (c.z + c.w)) + ((d.x + d.y) + (d.z + d.w));
    return __builtin_amdgcn_rsqf(s * (1.0f / D) + EPS);
}

struct EpiIn {
    static constexpr bool RINV = true, SUMSQ = false, FENCE_QUAD = false;
    const float* ss; float* ss_out; f16* gg; f16* xb; float* pconv; float* sconv;
    __device__ __forceinline__ float quad(int row, int col, f32x4 v, float rinv) const {
        v *= rinv;
        if (col < D) { f32x4 g; g.x = gelu_tanh(v.x); g.y = gelu_tanh(v.y); g.z = gelu_tanh(v.z); g.w = gelu_tanh(v.w); *(h4*)(gg + (size_t)row * D + col) = cvt_h4(g); }
        else { const int c = col - D; *(h4*)(xb + (size_t)row * D + c) = cvt_h4(v);
            bool smp; int b, t; row_bt(row, smp, b, t);
            if (!smp) { if (t >= SEQ - 3) *(f32x4*)(pconv + ((size_t)b * 3 + (t - (SEQ - 3))) * D + c) = v; }
            else { if (t >= 1) *(f32x4*)(sconv + ((size_t)b * 3 + (t - 1)) * D + c) = v; } }
        return 0.f;
    }
};
struct EpiGate {
    static constexpr bool RINV = false, SUMSQ = false, FENCE_QUAD = true;
    const float* ss; float* ss_out; const float* rb; const float* ib; const float* lam; const f16* xc; float* la; float* ix;
    __device__ __forceinline__ float quad(int row, int col, f32x4 v, float) const {
        const int blk = col >> 9, ri = (col >> 8) & 1, ch = blk * 256 + (col & 255);
        if (ri == 0) { const f32x4 bb = *(const f32x4*)(rb + ch), lm = *(const f32x4*)(lam + ch); f32x4 o;
            o.x = sigmoidf_(v.x + bb.x) * lm.x; o.y = sigmoidf_(v.y + bb.y) * lm.y; o.z = sigmoidf_(v.z + bb.z) * lm.z; o.w = sigmoidf_(v.w + bb.w) * lm.w;
            *(f32x4*)(la + (size_t)row * D + ch) = o; }
        else { const f32x4 bb = *(const f32x4*)(ib + ch); const f32x4 x = cvt_f4(*(const h4*)(xc + (size_t)row * D + ch)); f32x4 o;
            o.x = sigmoidf_(v.x + bb.x) * x.x; o.y = sigmoidf_(v.y + bb.y) * x.y; o.z = sigmoidf_(v.z + bb.z) * x.z; o.w = sigmoidf_(v.w + bb.w) * x.w;
            *(f32x4*)(ix + (size_t)row * D + ch) = o; }
        return 0.f;
    }
};
struct EpiRes {
    static constexpr bool RINV = false, SUMSQ = true, FENCE_QUAD = false;
    const float* ss; float* ss_out; const float* xin_p; const float* xin_s; float* xout; f16* xh;
    __device__ __forceinline__ float quad(int row, int col, f32x4 v, float) const {
        const float* src = row < MP ? xin_p + (size_t)row * D + col : xin_s + (size_t)(row - MP) * D + col;
        const f32x4 xn = *(const f32x4*)src + v;
        *(f32x4*)(xout + (size_t)row * D + col) = xn; *(h4*)(xh + (size_t)row * D + col) = cvt_h4(xn);
        return (xn.x * xn.x + xn.y * xn.y) + (xn.z * xn.z + xn.w * xn.w);
    }
};
struct EpiUp {
    static constexpr bool RINV = true, SUMSQ = false, FENCE_QUAD = false;
    const float* ss; float* ss_out; f16* g; f16* v; float* pffn; float* sffn;
    __device__ __forceinline__ float quad(int row, int col, f32x4 a, float rinv) const {
        a *= rinv;
        if (col < DFF) { *(h4*)(g + (size_t)row * DFF + col) = cvt_h4(a);
            bool smp; int b, t; row_bt(row, smp, b, t);
            if (!smp) { if (t >= SEQ - 2) *(f32x4*)(pffn + ((size_t)b * 2 + (t - (SEQ - 2))) * DFF + col) = a; }
            else { if (t >= 2) *(f32x4*)(sffn + ((size_t)b * 2 + (t - 2)) * DFF + col) = a; } }
        else *(h4*)(v + (size_t)row * DFF + (col - DFF)) = cvt_h4(a);
        return 0.f;
    }
};
struct EpiRaw {
    static constexpr bool RINV = true, SUMSQ = false, FENCE_QUAD = false;
    const float* ss; float* ss_out; float* raw; int ld;
    __device__ __forceinline__ float quad(int row, int col, f32x4 a, float rinv) const { *(f32x4*)(raw + (size_t)row * ld + col) = a * rinv; return 0.f; }
};
template <class E> struct Pg8Epi {
    E e;
    __device__ __forceinline__ void operator()(const f32x4 (&acc)[2][2][4][2], const pg8::Unit& u, int wr, int wc, int fr, int fq) const {
        const int row0 = u.pm * 256 + wr * 64 + fr, col0 = u.pn * 256 + wc * 32 + 4 * fq;
#pragma unroll
        for (int ai = 0; ai < 2; ++ai)
#pragma unroll
            for (int m = 0; m < 4; ++m) {
                const int row = row0 + ai * 128 + m * 16;
                float rinv = 1.0f; if (E::RINV) rinv = row_rinv(e.ss, row);
                float s = 0.f;
#pragma unroll
                for (int bj = 0; bj < 2; ++bj)
#pragma unroll
                    for (int n = 0; n < 2; ++n) { s += e.quad(row, col0 + bj * 128 + n * 16, acc[ai][bj][m][n], rinv); if (E::FENCE_QUAD) asm volatile("" ::: "memory"); }
                if (E::SUMSQ) { s += __shfl_xor(s, 16); s += __shfl_xor(s, 32); if (fq == 0) e.ss_out[(size_t)row * 16 + u.pn * 4 + wc] = s; }
                asm volatile("" ::: "memory");
            }
    }
};

template <class E>
__device__ __forceinline__ void mini_gemm(Ctx& C, const f16* A, int lda, const f16* Bt, int ldb, int N, int K, int a_pn_bytes, const E& e) {
    const int tid_o = opq_tid(), lane_o = tid_o & 63, wave_o = __builtin_amdgcn_readfirstlane(tid_o >> 6); (void)lane_o; (void)wave_o;
    LAS float* P = (LAS float*)C.lds;
    const int lane = lane_o, w = wave_o, nunits = 16 * (N / 64), ks = K / 8, l15 = lane & 15, lq = lane >> 4;
    for (int u = C.bid; u < nunits; u += C.G) {
        const int rb = u & 15, cb = u >> 4;
        const int acol = ((cb * 64) >> 9) * (a_pn_bytes >> 1);
        f32x4 acc[2][4];
#pragma unroll
        for (int r = 0; r < 2; ++r)
#pragma unroll
            for (int c = 0; c < 4; ++c) acc[r][c] = (f32x4){0.f, 0.f, 0.f, 0.f};
        const f16* ap = A + (size_t)(MP + 32 * rb + l15) * lda + acol + w * ks + 8 * lq;
        const f16* bp = Bt + (size_t)(64 * cb + l15) * ldb + w * ks + 8 * lq;
        for (int kk = 0; kk < ks; kk += 32) {
            h8 a[2], b[4];
#pragma unroll
            for (int r = 0; r < 2; ++r) a[r] = *(const h8*)(ap + (size_t)(16 * r) * lda + kk);
#pragma unroll
            for (int c = 0; c < 4; ++c) b[c] = *(const h8*)(bp + (size_t)(16 * c) * ldb + kk);
#pragma unroll
            for (int r = 0; r < 2; ++r)
#pragma unroll
                for (int c = 0; c < 4; ++c) acc[r][c] = __builtin_amdgcn_mfma_f32_16x16x32_f16(a[r], b[c], acc[r][c], 0, 0, 0);
        }
#pragma unroll
        for (int r = 0; r < 2; ++r)
#pragma unroll
            for (int c = 0; c < 4; ++c)
#pragma unroll
                for (int e2 = 0; e2 < 4; ++e2) P[(w * 32 + 16 * r + 4 * lq + e2) * 64 + 16 * c + l15] = acc[r][c][e2];
        __syncthreads();
        {
            const int row = tid_o >> 4, cq = (tid_o & 15) * 4;
            f32x4 v = (f32x4){0.f, 0.f, 0.f, 0.f};
#pragma unroll
            for (int ww = 0; ww < 8; ++ww) v += *(const LAS f32x4*)(P + (ww * 32 + row) * 64 + cq);
            const int grow = MP + 32 * rb + row, gcol = 64 * cb + cq;
            float rinv = 1.0f; if (E::RINV) rinv = row_rinv(e.ss, grow);
            float s = e.quad(grow, gcol, v, rinv);
            if (E::SUMSQ) { s += __shfl_xor(s, 1); s += __shfl_xor(s, 2); s += __shfl_xor(s, 4); s += __shfl_xor(s, 8); if ((tid_o & 15) == 0) e.ss_out[(size_t)grow * 16 + cb] = s; }
        }
        __syncthreads();
    }
}

template <class E>
__device__ __forceinline__ void gemm_both(Ctx& C, const f16* A, int lda, const f16* Bt, int ldb, int N, int K, int a_pn_bytes, const E& e) {
    pg8::Gemm g{A, Bt, lda, ldb, MP, N, K, a_pn_bytes}; pg8::StaticOrder S; S.init(MP, N, C.G, C.bid);
    Pg8Epi<E> pe{e};
    pg8::gemm_phase<Pg8Epi<E>>(C.lds, g, S, pe);
    VM_WAIT(); __syncthreads();
    mini_gemm<E>(C, A, lda, Bt, ldb, N, K, a_pn_bytes, e);
}

__device__ __forceinline__ unsigned pk2h(float lo, float hi) { const h2 a = __builtin_convertvector((f32x2){lo, hi}, h2); return __builtin_bit_cast(unsigned, a); }
__device__ __forceinline__ void tr_item(const float* W, int N, f16* WT, int ldt, int row_off, const float* gain, LAS float* scr, int item, int lane) {
    const int nblk = N / 32, kb = item / nblk, nb = item % nblk, k0 = 64 * kb, n0 = 32 * nb;
#pragma unroll 8
    for (int i = 0; i < 32; ++i) { const int kk = 2 * i + (lane >> 5); const float gv = gain ? gain[k0 + kk] : 1.0f; scr[kk * 33 + (lane & 31)] = W[(size_t)(k0 + kk) * N + n0 + (lane & 31)] * gv; }
    LDS_WAIT(); asm volatile("" ::: "memory");
    const int c = lane & 7;
#pragma unroll
    for (int j = 0; j < 4; ++j) { const int n = (lane >> 3) + 8 * j; const LAS float* s = scr + (8 * c) * 33 + n;
        u32x4 o; o.x = pk2h(s[0 * 33], s[1 * 33]); o.y = pk2h(s[2 * 33], s[3 * 33]); o.z = pk2h(s[4 * 33], s[5 * 33]); o.w = pk2h(s[6 * 33], s[7 * 33]);
        *(u32x4*)(WT + (size_t)(row_off + n0 + n) * ldt + k0 + 8 * c) = o; }
    LDS_WAIT(); asm volatile("" ::: "memory");
}
__device__ __forceinline__ void p0_prologue(Ctx& C) {
    const int tid_o = opq_tid(), lane_o = tid_o & 63, wave_o = __builtin_amdgcn_readfirstlane(tid_o >> 6); (void)lane_o; (void)wave_o;
    LAS float* scr = (LAS float*)(C.lds + wave_o * 16384);
    const int gw = C.bid * NWAVES + wave_o, NGW = C.G * NWAVES, lane = lane_o;
    const float* const* in = C.in;
    constexpr int NITEMS = 2048 + 512 + 1024 + 512 + 768 + 768 + 512 + 12288 + 6144;
    for (int it = gw; it < NITEMS; it += NGW) {
        int r = it;
        if (r < 2048) { const int l = r >> 10; tr_item(in[8] + (size_t)l * D * 2048, 2048, WSP(f16, WS_WIN) + (size_t)l * 2048 * D, D, 0, in[7] + l * D, scr, r & 1023, lane); continue; } r -= 2048;
        if (r < 512) { const int l = r >> 8, rr = r & 255, blk = rr >> 6, ri = (rr >> 5) & 1, item = rr & 31;
            tr_item((ri ? in[13] : in[11]) + ((size_t)l * 4 + blk) * 65536, 256, WSP(f16, WS_WG) + (size_t)l * 2048 * 256, 256, blk * 512 + ri * 256, nullptr, scr, item, lane); continue; } r -= 512;
        if (r < 1024) { const int l = r >> 9; tr_item(in[16] + (size_t)l * D * D, D, WSP(f16, WS_WOUT) + (size_t)l * D * D, D, 0, nullptr, scr, r & 511, lane); continue; } r -= 1024;
        if (r < 512) { tr_item(in[18], 1024, WSP(f16, WS_WKVQ), D, 0, in[17], scr, r, lane); continue; } r -= 512;
        if (r < 768) { tr_item(in[21], 1536, WSP(f16, WS_WKVQ), D, 1024, in[20], scr, r, lane); continue; } r -= 768;
        if (r < 768) { tr_item(in[21] + (size_t)D * 1536, 1536, WSP(f16, WS_WQ1), D, 0, in[20] + D, scr, r, lane); continue; } r -= 768;
        if (r < 512) { const int j = r >> 8; tr_item(in[23] + (size_t)j * 512 * D, D, WSP(f16, WS_WO) + (size_t)j * D * 512, 512, 0, nullptr, scr, r & 255, lane); continue; } r -= 512;
        if (r < 12288) { const int l = r / 3072; tr_item(in[25] + (size_t)l * D * 6144, 6144, WSP(f16, WS_WUP) + (size_t)l * 6144 * D, D, 0, in[24] + l * D, scr, r % 3072, lane); continue; } r -= 12288;
        { const int l = r / 1536; tr_item(in[28] + (size_t)l * DFF * D, D, WSP(f16, WS_WDN) + (size_t)l * D * DFF, DFF, 0, nullptr, scr, r % 1536, lane); }
    }
    for (int i = C.bid * 512 + tid_o; i < 2 * D; i += C.G * 512) WSP(float, WS_SPL)[i] = -8.0f * log1pf(expf(-in[15][i]));
    f16* xh = WSP(f16, WS_XH); float* ss = WSP(float, WS_SS);
    for (int m = gw; m < M; m += NGW) {
        const float* xrow = m < MP ? in[0] + (size_t)m * D : in[1] + (size_t)(m - MP) * D;
        float s = 0.f;
#pragma unroll
        for (int j = 0; j < 4; ++j) { const f32x4 v = *(const f32x4*)(xrow + 4 * lane + 256 * j); s += (v.x * v.x + v.y * v.y) + (v.z * v.z + v.w * v.w); *(h4*)(xh + (size_t)m * D + 4 * lane + 256 * j) = cvt_h4(v); }
        s = wave_sum(s);
        if (lane < 16) ss[(size_t)m * 16 + lane] = lane == 0 ? s : 0.f;
    }
}

__device__ __forceinline__ void e1_conv_a(Ctx& C, int l) {
    const int tid_o = opq_tid(), lane_o = tid_o & 63, wave_o = __builtin_amdgcn_readfirstlane(tid_o >> 6); (void)lane_o; (void)wave_o;
    const f16* xb = WSP(f16, WS_XB); f16* xc = WSP(f16, WS_XC);
    const float* cw = C.in[9] + (size_t)l * 4 * D; const float* cb = C.in[10] + (size_t)l * D; const float* st = C.in[5] + (size_t)l * BS * 3 * D;
    const size_t total = (size_t)M * (D / 8), stride = (size_t)C.G * 512;
    for (size_t it = (size_t)C.bid * 512 + tid_o; it < total; it += stride) {
        const int row = (int)(it >> 7), c = (int)(it & 127) * 8;
        bool smp; int b, t; row_bt(row, smp, b, t);
        float acc[8];
#pragma unroll
        for (int e = 0; e < 8; ++e) acc[e] = cb[c + e];
#pragma unroll
        for (int j = 0; j < 4; ++j) {
            const int tt = t - 3 + j; float xv[8];
            if (tt >= 0) { const h8 v = *(const h8*)(xb + (size_t)(row - 3 + j) * D + c);
#pragma unroll
                for (int e = 0; e < 8; ++e) xv[e] = (float)v[e]; }
            else if (smp) { const float* p = st + ((size_t)b * 3 + (t + j)) * D + c;
#pragma unroll
                for (int e = 0; e < 8; ++e) xv[e] = p[e]; }
            else {
#pragma unroll
                for (int e = 0; e < 8; ++e) xv[e] = 0.f; }
#pragma unroll
            for (int e = 0; e < 8; ++e) acc[e] += cw[j * D + c + e] * xv[e];
        }
        h8 o;
#pragma unroll
        for (int e = 0; e < 8; ++e) o[e] = (f16)acc[e];
        *(h8*)(xc + (size_t)row * D + c) = o;
    }
}
__device__ __forceinline__ void e2a_scan_carry(Ctx& C) {
    const int tid_o = opq_tid(), lane_o = tid_o & 63, wave_o = __builtin_amdgcn_readfirstlane(tid_o >> 6); (void)lane_o; (void)wave_o;
    const float* la = WSP(float, WS_LA); const float* ix = WSP(float, WS_IX); float* ca = WSP(float, WS_CA); float* chh = WSP(float, WS_CH);
    const int total = BP * 32 * D;
    for (int it = C.bid * 512 + tid_o; it < total; it += C.G * 512) {
        const int c = it & (D - 1), k = (it >> 10) & 31, b = it >> 15;
        const size_t base = ((size_t)b * SEQ + k * 128) * D + c;
        float Ap = 1.f, H = 0.f;
#pragma unroll 8
        for (int t = 0; t < 128; ++t) { const float l2 = la[base + (size_t)t * D], xi = ix[base + (size_t)t * D];
            const float a = __expf(l2), u = sqrtf(-expm1f(2.0f * l2)) * xi; Ap *= a; H = a * H + u; }
        ca[it] = Ap; chh[it] = H;
    }
}
__device__ __forceinline__ void e2b_scan_apply(Ctx& C, int l) {
    const int tid_o = opq_tid(), lane_o = tid_o & 63, wave_o = __builtin_amdgcn_readfirstlane(tid_o >> 6); (void)lane_o; (void)wave_o;
    const float* la = WSP(float, WS_LA); const float* ix = WSP(float, WS_IX); const float* ca = WSP(float, WS_CA); const float* chh = WSP(float, WS_CH);
    const f16* gg = WSP(f16, WS_GG); f16* y = WSP(f16, WS_Y);
    const int totalp = BP * 32 * D, totals = BS * D;
    for (int it = C.bid * 512 + tid_o; it < totalp + totals; it += C.G * 512) {
        if (it < totalp) {
            const int c = it & (D - 1), k = (it >> 10) & 31, b = it >> 15;
            float h = 0.f;
            for (int j = 0; j < k; ++j) { const int ci = ((b * 32 + j) << 10) + c; h = ca[ci] * h + chh[ci]; }
            const size_t base = ((size_t)b * SEQ + k * 128) * D + c;
#pragma unroll 8
            for (int t = 0; t < 128; ++t) { const size_t o = base + (size_t)t * D; const float l2 = la[o], xi = ix[o];
                const float a = __expf(l2), u = sqrtf(-expm1f(2.0f * l2)) * xi; h = a * h + u; y[o] = (f16)(h * (float)gg[o]); }
            if (k == 31) C.out[O_PH + ((size_t)l * BP + b) * D + c] = h;
        } else {
            const int i2 = it - totalp, c = i2 & (D - 1), b = i2 >> 10;
            float h = C.in[4][((size_t)l * BS + b) * D + c];
            const size_t base = ((size_t)MP + b * 4) * D + c;
#pragma unroll
            for (int t = 0; t < 4; ++t) { const size_t o = base + (size_t)t * D; const float l2 = la[o], xi = ix[o];
                const float a = __expf(l2), u = sqrtf(-expm1f(2.0f * l2)) * xi; h = a * h + u; y[o] = (f16)(h * (float)gg[o]); }
            C.out[O_SH + ((size_t)l * BS + b) * D + c] = h;
        }
    }
}
__device__ __forceinline__ void e3_geglu(Ctx& C, int L) {
    const int tid_o = opq_tid(), lane_o = tid_o & 63, wave_o = __builtin_amdgcn_readfirstlane(tid_o >> 6); (void)lane_o; (void)wave_o;
    const f16* g = WSP(f16, WS_G); const f16* v = WSP(f16, WS_V); f16* mid = WSP(f16, WS_MID);
    const float* cw = C.in[26] + (size_t)L * 3 * DFF; const float* cb = C.in[27] + (size_t)L * DFF; const float* st = C.in[6] + (size_t)L * BS * 2 * DFF;
    const size_t total = (size_t)M * (DFF / 8), stride = (size_t)C.G * 512;
    for (size_t it = (size_t)C.bid * 512 + tid_o; it < total; it += stride) {
        const int row = (int)(it / 384), c = (int)(it % 384) * 8;
        bool smp; int b, t; row_bt(row, smp, b, t);
        float acc[8];
#pragma unroll
        for (int e = 0; e < 8; ++e) acc[e] = cb[c + e];
#pragma unroll
        for (int j = 0; j < 3; ++j) {
            const int tt = t - 2 + j; float xv[8];
            if (tt >= 0) { const h8 q = *(const h8*)(g + (size_t)(row - 2 + j) * DFF + c);
#pragma unroll
                for (int e = 0; e < 8; ++e) xv[e] = (float)q[e]; }
            else if (smp) { const float* p = st + ((size_t)b * 2 + (t + j)) * DFF + c;
#pragma unroll
                for (int e = 0; e < 8; ++e) xv[e] = p[e]; }
            else {
#pragma unroll
                for (int e = 0; e < 8; ++e) xv[e] = 0.f; }
#pragma unroll
            for (int e = 0; e < 8; ++e) acc[e] += cw[j * DFF + c + e] * xv[e];
        }
        const h8 vv = *(const h8*)(v + (size_t)row * DFF + c);
        h8 o;
#pragma unroll
        for (int e = 0; e < 8; ++e) o[e] = (f16)(gelu_tanh(acc[e]) * (float)vv[e]);
        *(h8*)(mid + (size_t)row * DFF + c) = o;
    }
}
__constant__ float ROPE_INV[8] = {1.0f, 0.19392274474868576f, 0.03760603093086393f, 0.007292664737217109f, 0.001414213562373095f, 0.0002742481756762073f, 5.318295896944988e-05f, 1.031338537721246e-05f};
__device__ __forceinline__ void e4_headnorm_rope(Ctx& C, int mode) {
    const int tid_o = opq_tid(), lane_o = tid_o & 63, wave_o = __builtin_amdgcn_readfirstlane(tid_o >> 6); (void)lane_o; (void)wave_o;
    const float* raw = WSP(float, WS_RAW); f16* kh = WSP(f16, WS_KH); f16* vh = WSP(f16, WS_VH); f16* qh = WSP(f16, WS_QH);
    const int nslot = mode == 0 ? 40 : 24, ld = mode == 0 ? 2560 : 1536, qbase = mode == 0 ? 16 : 0, jq = mode == 0 ? 0 : 1;
    const float* kg = C.in[19]; const float* qg = C.in[22] + jq * HD;
    const size_t total = (size_t)M * nslot, stride = (size_t)C.G * 32;
    const int sub = lane_o & 15, grp = tid_o >> 4;
    for (size_t it = (size_t)C.bid * 32 + grp; it < total; it += stride) {
        const int row = (int)(it / nslot), slot = (int)(it % nslot);
        bool smp; int b, t; row_bt(row, smp, b, t);
        f32x4 v = *(const f32x4*)(raw + (size_t)row * ld + slot * 64 + sub * 4);
        const bool isv = (mode == 0) && slot >= 8 && slot < 16;
        const bool isk = (mode == 0) && slot < 8;
        float s = (v.x * v.x + v.y * v.y) + (v.z * v.z + v.w * v.w);
        s += __shfl_xor(s, 1); s += __shfl_xor(s, 2); s += __shfl_xor(s, 4); s += __shfl_xor(s, 8);
        f32x4 o = v;
        if (!isv) {
            const float rn = __builtin_amdgcn_rsqf(s * (1.0f / HD) + EPS);
            const f32x4 gv = *(const f32x4*)((isk ? kg : qg) + sub * 4);
            o = v * rn * gv;
        }
        f32x4 p; p.x = __shfl_xor(o.x, 2); p.y = __shfl_xor(o.y, 2); p.z = __shfl_xor(o.z, 2); p.w = __shfl_xor(o.w, 2);
        if (!isv && sub < 4) {
            const float pos = (float)(smp ? NPAST + t : t);
            const int i0 = (sub & 1) * 4;
            float cs[4], sn[4];
#pragma unroll
            for (int e = 0; e < 4; ++e) { const float ang = pos * ROPE_INV[i0 + e]; cs[e] = cosf(ang); sn[e] = sinf(ang); }
            if (sub < 2) { o.x = o.x * cs[0] - p.x * sn[0]; o.y = o.y * cs[1] - p.y * sn[1]; o.z = o.z * cs[2] - p.z * sn[2]; o.w = o.w * cs[3] - p.w * sn[3]; }
            else { o.x = o.x * cs[0] + p.x * sn[0]; o.y = o.y * cs[1] + p.y * sn[1]; o.z = o.z * cs[2] + p.z * sn[2]; o.w = o.w * cs[3] + p.w * sn[3]; }
        }
        if (isk || isv) {
            const int h = slot & 7; f16* dst = isk ? kh : vh;
            *(h4*)(dst + (size_t)row * DKV + h * 64 + sub * 4) = cvt_h4(o);
            float* co = nullptr;
            if (!smp) { if (t >= SEQ - 2048) co = C.out + (isk ? O_PCK : O_PCV) + (((size_t)b * 2048 + (t - (SEQ - 2048))) * NH + h) * HD + sub * 4; }
            else co = C.out + (isk ? O_SCK : O_SCV) + (((size_t)b * 4 + t) * NH + h) * HD + sub * 4;
            if (co) *(f32x4*)co = o;
        } else {
            const int qs = slot - qbase;
            *(h4*)(qh + (size_t)row * 1536 + qs * 64 + sub * 4) = cvt_h4(o * 0.125f);
        }
    }
}
__device__ __forceinline__ void e5_merge(Ctx& C) {
    const int tid_o = opq_tid(), lane_o = tid_o & 63, wave_o = __builtin_amdgcn_readfirstlane(tid_o >> 6); (void)lane_o; (void)wave_o;
    const f16* og = WSP(f16, WS_OG); const float* lse = WSP(float, WS_LSE); f16* att = WSP(f16, WS_ATT);
    const size_t total = (size_t)M * NH * 8, stride = (size_t)C.G * 512;
    for (size_t it = (size_t)C.bid * 512 + tid_o; it < total; it += stride) {
        const int sub = (int)(it & 7), h = (int)((it >> 3) & 7), row = (int)(it >> 6);
        const float l0 = lse[((size_t)0 * M + row) * NH + h], l1 = lse[((size_t)1 * M + row) * NH + h], l2 = lse[((size_t)2 * M + row) * NH + h];
        const float mx = fmaxf(l0, fmaxf(l1, l2));
        float w0 = __expf(l0 - mx), w1 = __expf(l1 - mx), w2 = __expf(l2 - mx); const float inv = 1.0f / (w0 + w1 + w2); w0 *= inv; w1 *= inv; w2 *= inv;
        const size_t o = (size_t)row * DKV + h * 64 + sub * 8;
        const h8 a = *(const h8*)(og + o), b2 = *(const h8*)(og + (size_t)M * DKV + o), c2 = *(const h8*)(og + (size_t)2 * M * DKV + o);
        h8 r;
#pragma unroll
        for (int e = 0; e < 8; ++e) r[e] = (f16)(w0 * (float)a[e] + w1 * (float)b2[e] + w2 * (float)c2[e]);
        *(h8*)(att + o) = r;
    }
}

constexpr int KV_STRIDE = 144;
constexpr int KV_ROWS = 272;
constexpr int ATT_K_OFF = 0, ATT_V_OFF = KV_ROWS * KV_STRIDE;
__device__ __forceinline__ s16x4 tr_read(LAS unsigned char* p) { return __builtin_amdgcn_ds_read_tr16_b64_v4i16((LAS s16x4*)p); }
__device__ __forceinline__ void att_prompt(Ctx& C) {
    const int tid_o = opq_tid(), lane_o = tid_o & 63, wave_o = __builtin_amdgcn_readfirstlane(tid_o >> 6); (void)lane_o; (void)wave_o;
    const f16* qh = WSP(f16, WS_QH); const f16* kh = WSP(f16, WS_KH); const f16* vh = WSP(f16, WS_VH); f16* og = WSP(f16, WS_OG); float* lse = WSP(float, WS_LSE);
    LAS unsigned char* Ks = C.lds + ATT_K_OFF; LAS unsigned char* Vs = C.lds + ATT_V_OFF;
    const int tid = tid_o, lane = lane_o, w = wave_o, l15 = lane & 15, lq = lane >> 4;
    for (int i = tid; i < 16 * KV_STRIDE / 4; i += 512) { ((LAS unsigned*)(Vs + 256 * KV_STRIDE))[i] = 0u; ((LAS unsigned*)(Ks + 256 * KV_STRIDE))[i] = 0u; }
    __syncthreads();
    constexpr int NUNITS = BP * NH * 96;
    for (int u = C.bid; u < NUNITS; u += C.G) {
        const int x = u % 96, bh = u / 96, h = bh & 7, b = bh >> 3;
        int g, d, r, n;
        if (x < 32) { g = 0; d = 1; r = 0; n = x; } else if (x < 64) { g = 1; d = 4; r = (x - 32) >> 3; n = (x - 32) & 7; } else { g = 2; d = 16; r = (x - 64) >> 1; n = (x - 64) & 1; }
#pragma unroll
        for (int i = 0; i < 4; ++i) {
            const int ch = tid + 512 * i, kk = ch >> 3, c8 = ch & 7, mk = 128 * n - 128 + kk;
            u32x4 kv4 = (u32x4){0u, 0u, 0u, 0u}, vv4 = kv4;
            if (mk >= 0) { const size_t go = ((size_t)b * SEQ + (size_t)d * mk + r) * DKV + h * 64 + c8 * 8; kv4 = *(const u32x4*)(kh + go); vv4 = *(const u32x4*)(vh + go); }
            *(LAS u32x4*)(Ks + kk * KV_STRIDE + c8 * 16) = kv4; *(LAS u32x4*)(Vs + kk * KV_STRIDE + c8 * 16) = vv4;
        }
        const int qi = 16 * w + l15, mq = 128 * n + qi;
        const size_t qrow = (size_t)b * SEQ + (size_t)d * mq + r;
        const h8 q0 = *(const h8*)(qh + qrow * 1536 + g * 512 + h * 64 + 8 * lq), q1 = *(const h8*)(qh + qrow * 1536 + g * 512 + h * 64 + 32 + 8 * lq);
        __syncthreads();
        f32x4 s[10];
#pragma unroll
        for (int bb = 0; bb < 10; ++bb) {
            const LAS unsigned char* kp = Ks + (16 * w + 16 * bb + l15) * KV_STRIDE + 16 * lq;
            const h8 k0 = *(const LAS h8*)kp, k1 = *(const LAS h8*)(kp + 64);
            f32x4 a = (f32x4){0.f, 0.f, 0.f, 0.f};
            a = __builtin_amdgcn_mfma_f32_16x16x32_f16(k0, q0, a, 0, 0, 0);
            a = __builtin_amdgcn_mfma_f32_16x16x32_f16(k1, q1, a, 0, 0, 0);
            s[bb] = a;
        }
        float mx = -INFINITY;
#pragma unroll
        for (int bb = 0; bb < 10; ++bb)
#pragma unroll
            for (int e = 0; e < 4; ++e) { const int kk = 16 * w + 16 * bb + 4 * lq + e; const bool ok = (kk >= qi) && (kk <= qi + 128) && (128 * n - 128 + kk >= 0);
                s[bb][e] = ok ? s[bb][e] : -INFINITY; mx = fmaxf(mx, s[bb][e]); }
        mx = fmaxf(mx, __shfl_xor(mx, 16)); mx = fmaxf(mx, __shfl_xor(mx, 32));
        float den = 0.f;
#pragma unroll
        for (int bb = 0; bb < 10; ++bb)
#pragma unroll
            for (int e = 0; e < 4; ++e) { const float p = __expf(s[bb][e] - mx); s[bb][e] = p; den += p; }
        den += __shfl_xor(den, 16); den += __shfl_xor(den, 32);
        f32x4 o[4];
#pragma unroll
        for (int db = 0; db < 4; ++db) o[db] = (f32x4){0.f, 0.f, 0.f, 0.f};
#pragma unroll
        for (int c = 0; c < 5; ++c) {
            const h4 plo = cvt_h4(s[2 * c]), phi = cvt_h4(s[2 * c + 1]);
            const h8 pb = (h8){plo.x, plo.y, plo.z, plo.w, phi.x, phi.y, phi.z, phi.w};
            const int r0 = 16 * w + 32 * c + 4 * lq + (l15 >> 2);
#pragma unroll
            for (int db = 0; db < 4; ++db) {
                const s16x4 lo = tr_read(Vs + r0 * KV_STRIDE + (16 * db + 4 * (l15 & 3)) * 2), hi = tr_read(Vs + (r0 + 16) * KV_STRIDE + (16 * db + 4 * (l15 & 3)) * 2);
                const h4 vlo = __builtin_bit_cast(h4, lo), vhi = __builtin_bit_cast(h4, hi);
                const h8 va = (h8){vlo.x, vlo.y, vlo.z, vlo.w, vhi.x, vhi.y, vhi.z, vhi.w};
                o[db] = __builtin_amdgcn_mfma_f32_16x16x32_f16(va, pb, o[db], 0, 0, 0);
            }
        }
        const float inv = 1.0f / den;
        f16* orow = og + ((size_t)g * M + qrow) * DKV + h * 64;
#pragma unroll
        for (int db = 0; db < 4; ++db) *(h4*)(orow + 16 * db + 4 * lq) = cvt_h4(o[db] * inv);
        if (lq == 0) lse[((size_t)g * M + qrow) * NH + h] = mx + __logf(den);
        __syncthreads();
    }
}
__device__ __forceinline__ void att_sample(Ctx& C) {
    const int tid_o = opq_tid(), lane_o = tid_o & 63, wave_o = __builtin_amdgcn_readfirstlane(tid_o >> 6); (void)lane_o; (void)wave_o;
    const f16* qh = WSP(f16, WS_QH); const f16* kh = WSP(f16, WS_KH); const f16* vh = WSP(f16, WS_VH); f16* og = WSP(f16, WS_OG); float* lse = WSP(float, WS_LSE);
    const float* ck = C.in[2]; const float* cv = C.in[3];
    const int lane = lane_o, hh = lane >> 3, sub = lane & 7;
    const int gw = C.bid * NWAVES + wave_o, NGW = C.G * NWAVES;
    for (int u = gw; u < BS * NG * TS; u += NGW) {
        const int s = u & 3, g = (u >> 2) % 3, b = u / 12, d = g == 0 ? 1 : (g == 1 ? 4 : 16);
        const size_t qrow = (size_t)MP + b * 4 + s;
        float q[8];
        { const h8 qv = *(const h8*)(qh + qrow * 1536 + g * 512 + hh * 64 + sub * 8);
#pragma unroll
          for (int e = 0; e < 8; ++e) q[e] = (float)qv[e]; }
        float mx = -INFINITY, den = 0.f, o[8];
#pragma unroll
        for (int e = 0; e < 8; ++e) o[e] = 0.f;
#pragma unroll 4
        for (int j = 0; j <= 128; ++j) {
            const int idx = NPAST + s - d * j;
            float kf[8], vf[8];
            if (idx < NPAST) {
                const float* kp = ck + ((size_t)b * NPAST + idx) * DKV + lane * 8; const float* vp = cv + ((size_t)b * NPAST + idx) * DKV + lane * 8;
                const f32x4 k0 = *(const f32x4*)kp, k1 = *(const f32x4*)(kp + 4), v0 = *(const f32x4*)vp, v1 = *(const f32x4*)(vp + 4);
                kf[0] = k0.x; kf[1] = k0.y; kf[2] = k0.z; kf[3] = k0.w; kf[4] = k1.x; kf[5] = k1.y; kf[6] = k1.z; kf[7] = k1.w;
                vf[0] = v0.x; vf[1] = v0.y; vf[2] = v0.z; vf[3] = v0.w; vf[4] = v1.x; vf[5] = v1.y; vf[6] = v1.z; vf[7] = v1.w;
            } else {
                const size_t ro = ((size_t)MP + b * 4 + (idx - NPAST)) * DKV + lane * 8;
                const h8 k8 = *(const h8*)(kh + ro), v8 = *(const h8*)(vh + ro);
#pragma unroll
                for (int e = 0; e < 8; ++e) { kf[e] = (float)k8[e]; vf[e] = (float)v8[e]; }
            }
            float sc = 0.f;
#pragma unroll
            for (int e = 0; e < 8; ++e) sc += q[e] * kf[e];
            sc += __shfl_xor(sc, 1); sc += __shfl_xor(sc, 2); sc += __shfl_xor(sc, 4);
            const float mn = fmaxf(mx, sc), scale = __expf(mx - mn), p = __expf(sc - mn);
            den = den * scale + p;
#pragma unroll
            for (int e = 0; e < 8; ++e) o[e] = o[e] * scale + p * vf[e];
            mx = mn;
        }
        const float inv = 1.0f / den;
        h8 r;
#pragma unroll
        for (int e = 0; e < 8; ++e) r[e] = (f16)(o[e] * inv);
        *(h8*)(og + ((size_t)g * M + qrow) * DKV + hh * 64 + sub * 8) = r;
        if (sub == 0) lse[((size_t)g * M + qrow) * NH + hh] = mx + __logf(den);
    }
}

constexpr int NPHASE = 45;
__host__ __device__ constexpr bool phase_exists(int k) {
    if (k == 0) return true;
    const int L = (k - 1) / 11, p = (k - 1) % 11;
    if (L < 2) { if (p <= 8) return true; return L == 1; }
    if (p == 3 || p == 4 || p == 5) return false;
    if (p <= 8) return true;
    return L == 2;
}
__global__ void __launch_bounds__(NWAVES * 64, 2) fwd_kernel(Args args) {
    extern __shared__ __attribute__((aligned(16))) unsigned char lds_raw[];
    Ctx C;
    C.lds = (LAS unsigned char*)lds_raw;
    C.G = gridDim.x; C.bid = blockIdx.x;
    C.in = args.in; C.out = args.out; C.ws = args.ws;
    volatile LAS unsigned* MISC = (volatile LAS unsigned*)(C.lds + MISC_OFF);
    for (int u = threadIdx.x; u < (LDS_BYTES - LDSCTL_OFF) / 4; u += NWAVES * 64) ((LAS unsigned*)(C.lds + LDSCTL_OFF))[u] = 0u;
    __syncthreads();
    const int lo = args.ph_lo, hi = args.ph_hi;
    const bool multi = (hi - lo) > 1;
    XcdBarrier bar; bar.bar = (unsigned*)(C.ws + WS_CTL) + CW_BAR; bar.x = 0; bar.st = nullptr;
    if (multi) bar = xcd_barrier_post((unsigned*)(C.ws + WS_CTL) + CW_BAR, MISC + 8);
#ifndef PHASE_MASK
#define PHASE_MASK 0xFFFFFFFFu
#endif
#define PHM(b) ((PHASE_MASK >> (b)) & 1u)
#define IN(k) (lo <= (k) && (k) < hi)
#define SEAM(k) do { if (multi && (k) + 1 < hi) xcd_barrier(bar); } while (0)

    if (PHM(0) && IN(0)) { p0_prologue(C); SEAM(0); }

    for (int L = 0; L < 4; ++L) {
        const int pb = 1 + 11 * L;
        if (L < 2) {
            if (PHM(1) && IN(pb + 0)) {
                EpiIn e{WSP(float, WS_SS), nullptr, WSP(f16, WS_GG), WSP(f16, WS_XB), C.out + O_PCONV + (size_t)L * BP * 3 * D, C.out + O_SCONV + (size_t)L * BS * 3 * D};
                gemm_both<EpiIn>(C, WSP(f16, WS_XH), D, WSP(f16, WS_WIN) + (size_t)L * 2048 * D, D, 2048, D, 0, e); SEAM(pb + 0); }
            if (PHM(2) && IN(pb + 1)) { e1_conv_a(C, L); SEAM(pb + 1); }
            if (PHM(3) && IN(pb + 2)) {
                EpiGate e{nullptr, nullptr, C.in[12] + (size_t)L * D, C.in[14] + (size_t)L * D, WSP(float, WS_SPL) + (size_t)L * D, WSP(f16, WS_XC), WSP(float, WS_LA), WSP(float, WS_IX)};
                gemm_both<EpiGate>(C, WSP(f16, WS_XC), D, WSP(f16, WS_WG) + (size_t)L * 2048 * 256, 256, 2048, 256, 512, e); SEAM(pb + 2); }
            if (PHM(4) && IN(pb + 3)) { e2a_scan_carry(C); SEAM(pb + 3); }
            if (PHM(5) && IN(pb + 4)) { e2b_scan_apply(C, L); SEAM(pb + 4); }
            if (PHM(6) && IN(pb + 5)) {
                EpiRes e{nullptr, WSP(float, WS_SS), L == 0 ? C.in[0] : WSP(float, WS_XRES), L == 0 ? C.in[1] : WSP(float, WS_XRES) + (size_t)MP * D, WSP(float, WS_XRES), WSP(f16, WS_XH)};
                gemm_both<EpiRes>(C, WSP(f16, WS_Y), D, WSP(f16, WS_WOUT) + (size_t)L * D * D, D, D, D, 0, e); SEAM(pb + 5); }
        } else {
            if (PHM(7) && IN(pb + 0)) { att_prompt(C); att_sample(C); SEAM(pb + 0); }
            if (PHM(8) && IN(pb + 1)) { e5_merge(C); SEAM(pb + 1); }
            if (PHM(9) && IN(pb + 2)) {
                EpiRes e{nullptr, WSP(float, WS_SS), WSP(float, WS_XRES), WSP(float, WS_XRES) + (size_t)MP * D, WSP(float, WS_XRES), WSP(f16, WS_XH)};
                gemm_both<EpiRes>(C, WSP(f16, WS_ATT), 512, WSP(f16, WS_WO) + (size_t)(L - 2) * D * 512, 512, D, 512, 0, e); SEAM(pb + 2); }
        }
        if (PHM(10) && IN(pb + 6)) {
            EpiUp e{WSP(float, WS_SS), nullptr, WSP(f16, WS_G), WSP(f16, WS_V), C.out + O_PFFN + (size_t)L * BP * 2 * DFF, C.out + O_SFFN + (size_t)L * BS * 2 * DFF};
            gemm_both<EpiUp>(C, WSP(f16, WS_XH), D, WSP(f16, WS_WUP) + (size_t)L * 6144 * D, D, 6144, D, 0, e); SEAM(pb + 6); }
        if (PHM(11) && IN(pb + 7)) { e3_geglu(C, L); SEAM(pb + 7); }
        if (PHM(12) && IN(pb + 8)) {
            EpiRes e{nullptr, WSP(float, WS_SS), WSP(float, WS_XRES), WSP(float, WS_XRES) + (size_t)MP * D, L == 3 ? C.out : WSP(float, WS_XRES), WSP(f16, WS_XH)};
            gemm_both<EpiRes>(C, WSP(f16, WS_MID), DFF, WSP(f16, WS_WDN) + (size_t)L * D * DFF, DFF, D, DFF, 0, e); SEAM(pb + 8); }
        if (L == 1) {
            if (PHM(13) && IN(pb + 9)) { EpiRaw e{WSP(float, WS_SS), nullptr, WSP(float, WS_RAW), 2560};
                gemm_both<EpiRaw>(C, WSP(f16, WS_XH), D, WSP(f16, WS_WKVQ), D, 2560, D, 0, e); SEAM(pb + 9); }
            if (PHM(14) && IN(pb + 10)) { e4_headnorm_rope(C, 0); SEAM(pb + 10); }
        }
        if (L == 2) {
            if (PHM(13) && IN(pb + 9)) { EpiRaw e{WSP(float, WS_SS), nullptr, WSP(float, WS_RAW), 1536};
                gemm_both<EpiRaw>(C, WSP(f16, WS_XH), D, WSP(f16, WS_WQ1), D, 1536, D, 0, e); SEAM(pb + 9); }
            if (PHM(14) && IN(pb + 10)) { e4_headnorm_rope(C, 1); SEAM(pb + 10); }
        }
    }
#undef IN
#undef SEAM
}

#ifndef N_LAUNCH_MODE
#define N_LAUNCH_MODE 0
#endif
extern "C" void kernel_launch(void* const* d_in, const int* in_sizes, int n_in, void* d_out, int out_size, void* d_ws, size_t ws_size, hipStream_t stream) {
    static int grid = 0;
    if (grid == 0) {
        if (n_in != 29 || ws_size < WS_END) { fprintf(stderr, "kernel_launch: unexpected n_in %d or ws %zu (< %zu)\n", n_in, ws_size, (size_t)WS_END); grid = -1; return; }
        int dev = 0, cus = 0, per_cu = 0;
        if (hipGetDevice(&dev) != hipSuccess || hipDeviceGetAttribute(&cus, hipDeviceAttributeMultiprocessorCount, dev) != hipSuccess) { grid = -1; return; }
        if (hipFuncSetAttribute((const void*)fwd_kernel, hipFuncAttributeMaxDynamicSharedMemorySize, LDS_BYTES) != hipSuccess) { fprintf(stderr, "kernel_launch: hipFuncSetAttribute failed\n"); grid = -1; return; }
        if (hipOccupancyMaxActiveBlocksPerMultiprocessor(&per_cu, (const void*)fwd_kernel, NWAVES * 64, LDS_BYTES) != hipSuccess || per_cu < 1) fprintf(stderr, "kernel_launch: occupancy query says %d\n", per_cu);
        (void)hipGetLastError();
        grid = cus;
    }
    if (grid < 0) return;
    (void)hipMemsetAsync((char*)d_ws + WS_CTL, 0, CTL_ZERO_BYTES, stream);
    Args a{};
    for (int i = 0; i < 29; ++i) a.in[i] = (const float*)d_in[i];
    a.out = (float*)d_out; a.ws = (unsigned char*)d_ws;
#if N_LAUNCH_MODE == 1
    a.ph_lo = 0; a.ph_hi = NPHASE;
    hipLaunchKernelGGL(fwd_kernel, dim3(grid), dim3(NWAVES * 64), LDS_BYTES, stream, a);
#else
    for (int k = 0; k < NPHASE; ++k) {
        if (!phase_exists(k)) continue;
        a.ph_lo = k; a.ph_hi = k + 1;
        hipLaunchKernelGGL(fwd_kernel, dim3(grid), dim3(NWAVES * 64), LDS_BYTES, stream, a);
    }
#endif
}
```

```cpp
#include <hip/hip_runtime.h>
#include <cstdio>
#include <cstdint>

#ifndef REP_MASK
#define REP_MASK 0x0u
#endif
#ifndef REP_N
#define REP_N 1
#endif
#define LAS __attribute__((address_space(3)))
#define GAS __attribute__((address_space(1)))
typedef _Float16 f16;
typedef _Float16 h8 __attribute__((ext_vector_type(8)));
typedef _Float16 h4 __attribute__((ext_vector_type(4)));
typedef _Float16 h2 __attribute__((ext_vector_type(2)));
typedef float f32x4 __attribute__((ext_vector_type(4)));
typedef float f32x2 __attribute__((ext_vector_type(2)));
typedef unsigned u32x4 __attribute__((ext_vector_type(4)));
typedef unsigned u32x2 __attribute__((ext_vector_type(2)));
typedef short s16x4 __attribute__((ext_vector_type(4)));

constexpr int D = 1024, SEQ = 4096, BP = 4, MP = BP * SEQ, BS = 128, TS = 4, MS = BS * TS, M = MP + MS;
constexpr int DFF = 3072, NH = 8, HD = 64, NG = 3, DKV = NH * HD, NPAST = 2048;
constexpr float EPS = 1e-6f;

constexpr size_t O_YP = 0, O_YS = 16777216, O_PH = 17301504, O_PCONV = 17309696, O_PFFN = 17334272, O_PCK = 17432576, O_PCV = 21626880,
                 O_SH = 25821184, O_SCONV = 26083328, O_SFFN = 26869760, O_SCK = 30015488, O_SCV = 30277632;

constexpr size_t MiB = 1u << 20;
constexpr size_t WS_CTL = 0, CTL_ZERO_BYTES = 32768;
constexpr size_t WS_WIN = 2 * MiB;
constexpr size_t WS_WG = WS_WIN + 8 * MiB;
constexpr size_t WS_WOUT = WS_WG + 2 * MiB;
constexpr size_t WS_WKVQ = WS_WOUT + 4 * MiB;
constexpr size_t WS_WQ1 = WS_WKVQ + 5 * MiB;
constexpr size_t WS_WO = WS_WQ1 + 3 * MiB;
constexpr size_t WS_WUP = WS_WO + 2 * MiB;
constexpr size_t WS_WDN = WS_WUP + 48 * MiB;
constexpr size_t WS_XRES = WS_WDN + 24 * MiB;
constexpr size_t WS_XH = WS_XRES + 66 * MiB;
constexpr size_t WS_SS = WS_XH + 33 * MiB;
constexpr size_t WS_GG = WS_SS + 2 * MiB;
constexpr size_t WS_XB = WS_GG + 33 * MiB;
constexpr size_t WS_XC = WS_XB + 33 * MiB;
constexpr size_t WS_Y = WS_XC + 33 * MiB;
constexpr size_t WS_LA = WS_Y + 33 * MiB;
constexpr size_t WS_IX = WS_LA + 66 * MiB;
constexpr size_t WS_G = WS_IX + 66 * MiB;
constexpr size_t WS_V = WS_G + 99 * MiB;
constexpr size_t WS_MID = WS_V + 99 * MiB;
constexpr size_t WS_RAW = WS_MID + 99 * MiB;
constexpr size_t WS_KH = WS_RAW + 165 * MiB;
constexpr size_t WS_VH = WS_KH + 17 * MiB;
constexpr size_t WS_QH = WS_VH + 17 * MiB;
constexpr size_t WS_OG = WS_QH + 50 * MiB;
constexpr size_t WS_LSE = WS_OG + 50 * MiB;
constexpr size_t WS_ATT = WS_LSE + 2 * MiB;
constexpr size_t WS_CA = WS_ATT + 17 * MiB;
constexpr size_t WS_CH = WS_CA + 1 * MiB;
constexpr size_t WS_SPL = WS_CH + 1 * MiB;
constexpr size_t WS_SIDEF = WS_SPL + 1 * MiB;
constexpr size_t WS_SIDEL = WS_SIDEF + 3 * MiB;
constexpr size_t WS_ROPE = WS_SIDEL + 2 * MiB;
constexpr size_t WS_SIDEAF = WS_ROPE + 1 * MiB;
constexpr size_t WS_SIDEAL = WS_SIDEAF + 1 * MiB;
constexpr size_t WS_DUMX = WS_SIDEAL + 1 * MiB;
constexpr size_t WS_DUMH = WS_DUMX + 66 * MiB;
constexpr size_t WS_DUMS = WS_DUMH + 33 * MiB;
constexpr size_t WS_END = WS_DUMS + 2 * MiB;

constexpr int CW_BAR = 4096;
constexpr int NWAVES = 8;
constexpr int RING_BYTES = 131072, LDSCTL_OFF = RING_BYTES, MISC_OFF = LDSCTL_OFF + 320, HALO_OFF = RING_BYTES + 1024, LDS_BYTES = 147456;

namespace pg8 {
constexpr int BM = 256, BK = 64, HALF = 128, HTB = HALF * BK * 2, STAGE_BYTES = 8 * HTB, NXCD = 8, WGM = 8;
__host__ __device__ __forceinline__ int lds_byte(int r, int c) { const int st = (r >> 4) * 2 + (c >> 5), rr = r & 15, cc = c & 31, ob = rr * 64 + cc * 2; return st * 1024 + (ob ^ (((ob >> 9) & 1) << 5)); }
__host__ __device__ __forceinline__ void stage_rc(int b, int& R, int& C) { const int st = b / 1024, sb = b % 1024, swz = sb ^ (((sb >> 9) & 1) << 5); R = (st >> 1) * 16 + swz / 64; C = (st & 1) * 32 + (swz % 64) / 2; }
__host__ __device__ __forceinline__ int perm32(int rho) { const int n = rho >> 4, i = rho & 15; return 8 * (i >> 2) + 4 * n + (i & 3); }
struct Unit { int pm, pn; };
struct Gemm { const f16* A; const f16* Bt; int lda, ldb, M, N, K, a_pn_bytes, wave; };
struct StaticOrder {
    int nM, nN, nwg, G, c, dup;
    __device__ __forceinline__ void init(int M_, int N_, int G_, int c_) { nM = M_ / BM; nN = N_ / BM; nwg = nM * nN; G = G_; c = c_; dup = 0; }
    __device__ __forceinline__ bool next(int i, Unit& u) const {
        const long L = (long)(i >> dup) * G + c; if (L >= nwg) return false;
        int wgid = (int)L; { const int q = nwg / NXCD, r = nwg % NXCD, xcd = wgid % NXCD, off = wgid / NXCD; wgid = (xcd < r ? xcd * (q + 1) : r * (q + 1) + (xcd - r) * q) + off; }
        const int nig = WGM * nN, gid = wgid / nig, fm = gid * WGM, gsz = (nM - fm) < WGM ? (nM - fm) : WGM;
        u.pm = fm + ((wgid % nig) % gsz); u.pn = (wgid % nig) / gsz; return true;
    }
};
struct NoPost { __device__ __forceinline__ void operator()() const {} };
template <class Epi, class Post = NoPost>
__device__ __forceinline__ void gemm_phase(LAS unsigned char* lds, const Gemm g, const StaticOrder& S, const Epi& E, const Post& post = Post()) {
    int tid_; asm volatile("v_mbcnt_lo_u32_b32 %0, -1, 0\n\tv_mbcnt_hi_u32_b32 %0, -1, %0" : "=v"(tid_)); tid_ += g.wave * 64; asm volatile("" : "+v"(tid_));
    const int tid = tid_, wid = __builtin_amdgcn_readfirstlane(tid >> 6), lane = tid & 63, wr = wid >> 2, wc = wid & 3, fr = lane & 15, fq = lane >> 4;
    const int K = g.K, nt = K / BK;
    unsigned voffA[2], voffB[2];
#pragma unroll
    for (int i = 0; i < 2; ++i) { int R, C; stage_rc(tid * 16 + i * 8192, R, C); const int Rb = (R & ~31) + perm32(R & 31);
        voffA[i] = (unsigned)(R * g.lda + C) * 2u; voffB[i] = (unsigned)(Rb * g.ldb + C) * 2u; }
    const size_t kstep = (size_t)(BK * 2);
    const size_t hstepA = (size_t)HALF * g.lda * 2, hstepB = (size_t)HALF * g.ldb * 2;
    const size_t tstepA = 2 * hstepA, tstepB = 2 * hstepB;
    const unsigned ldsw = (unsigned)wid * 1024u;
    const int aoff = lds_byte(wr * 64 + fr, fq * 8), boff = lds_byte(wc * 32 + fr, fq * 8);
#define PG8_SA(b, h) (((b) * 2 + (h)) * HTB)
#define PG8_SB(b, h) ((4 + (b) * 2 + (h)) * HTB)
#define PG8_STAGE(bufoff, gbase, voff) do { _Pragma("unroll") for (int _i = 0; _i < 2; ++_i) \
        __builtin_amdgcn_global_load_lds((const unsigned*)((const char*)(gbase) + (voff)[_i]), (LAS unsigned*)(lds + (bufoff) + ldsw + _i * 8192), 16, 0, 0); } while (0)
#define PG8_LDA(dst, b, h) do { _Pragma("unroll") for (int m = 0; m < 4; ++m) _Pragma("unroll") for (int k = 0; k < 2; ++k) dst[m][k] = *(const LAS h8*)(lds + PG8_SA(b, h) + aoff + m * 2048 + k * 1024); } while (0)
#define PG8_LDB(dst, b, h) do { _Pragma("unroll") for (int n = 0; n < 2; ++n) _Pragma("unroll") for (int k = 0; k < 2; ++k) dst[n][k] = *(const LAS h8*)(lds + PG8_SB(b, h) + boff + n * 2048 + k * 1024); } while (0)
#define PG8_MMA(ai, bj, At, Bt) do { __builtin_amdgcn_s_setprio(1); _Pragma("unroll") for (int m = 0; m < 4; ++m) _Pragma("unroll") for (int n = 0; n < 2; ++n) _Pragma("unroll") for (int k = 0; k < 2; ++k) \
        acc[ai][bj][m][n] = __builtin_amdgcn_mfma_f32_16x16x32_f16(Bt[n][k], At[m][k], acc[ai][bj][m][n], 0, 0, 0); __builtin_amdgcn_s_setprio(0); } while (0)
#define PG8_WAIT_V(n) asm volatile("s_waitcnt vmcnt(" #n ")" ::: "memory")
#define PG8_WAIT_L(n) asm volatile("s_waitcnt lgkmcnt(" #n ")" ::: "memory")
#define PG8_BAR __builtin_amdgcn_s_barrier()
#define PG8_SCHED __builtin_amdgcn_sched_barrier(0)
    Unit cur, nxt; int ui = 0;
    if (!S.next(0, cur)) return;
    f32x4 acc[2][2][4][2];
#pragma unroll
    for (int a = 0; a < 2; ++a)
#pragma unroll
        for (int b = 0; b < 2; ++b)
#pragma unroll
            for (int m = 0; m < 4; ++m)
#pragma unroll
                for (int n = 0; n < 2; ++n) acc[a][b][m][n] = (f32x4){0.f, 0.f, 0.f, 0.f};
    h8 At[4][2], B0[2][2], B1[2][2];
    const char* cA = (const char*)g.A + (size_t)cur.pm * tstepA + (size_t)(cur.pn >> 1) * g.a_pn_bytes; const char* cB = (const char*)g.Bt + (size_t)cur.pn * tstepB;
    PG8_STAGE(PG8_SB(0, 0), cB, voffB); PG8_STAGE(PG8_SB(0, 1), cB + hstepB, voffB); PG8_STAGE(PG8_SA(0, 0), cA, voffA); PG8_STAGE(PG8_SA(0, 1), cA + hstepA, voffA);
    if (wr == 1) PG8_BAR;
    PG8_WAIT_V(2); PG8_BAR;
    PG8_STAGE(PG8_SB(1, 0), cB + kstep, voffB); PG8_STAGE(PG8_SA(1, 0), cA + kstep, voffA); PG8_STAGE(PG8_SB(1, 1), cB + hstepB + kstep, voffB);
    PG8_WAIT_V(6); PG8_BAR;
    for (;;) {
        const bool has_next = S.next(ui + 1, nxt);
        const char* nA = has_next ? (const char*)g.A + (size_t)nxt.pm * tstepA + (size_t)(nxt.pn >> 1) * g.a_pn_bytes : cA; const char* nB = has_next ? (const char*)g.Bt + (size_t)nxt.pn * tstepB : cB;
#pragma unroll 1
        for (int t = 0; t < nt; t += 2) {
            const bool last = (t == nt - 2);
            const char* a1 = cA + (size_t)(t + 1) * kstep;
            const char* a2 = last ? nA : cA + (size_t)(t + 2) * kstep; const char* b2 = last ? nB : cB + (size_t)(t + 2) * kstep;
            const char* a3 = a2 + kstep; const char* b3 = b2 + kstep;
            PG8_LDB(B0, 0, 0); PG8_LDB(B1, 0, 1); PG8_SCHED; PG8_LDA(At, 0, 0); PG8_STAGE(PG8_SA(1, 1), a1 + hstepA, voffA);
            PG8_WAIT_V(8); PG8_WAIT_L(0); PG8_BAR; PG8_MMA(0, 0, At, B0); PG8_MMA(0, 1, At, B1); PG8_BAR; PG8_SCHED;
            PG8_LDA(At, 0, 1); PG8_STAGE(PG8_SB(0, 0), b2, voffB); PG8_STAGE(PG8_SB(0, 1), b2 + hstepB, voffB); PG8_STAGE(PG8_SA(0, 0), a2, voffA);
            PG8_WAIT_V(8); PG8_WAIT_L(0); PG8_BAR; PG8_MMA(1, 0, At, B0); PG8_MMA(1, 1, At, B1); PG8_BAR; PG8_SCHED;
            PG8_LDB(B0, 1, 0); PG8_LDB(B1, 1, 1); PG8_SCHED; PG8_LDA(At, 1, 0); PG8_STAGE(PG8_SA(0, 1), a2 + hstepA, voffA);
            PG8_WAIT_V(8); PG8_WAIT_L(0); PG8_BAR; PG8_MMA(0, 0, At, B0); PG8_MMA(0, 1, At, B1); PG8_BAR; PG8_SCHED;
            PG8_LDA(At, 1, 1); PG8_STAGE(PG8_SB(1, 0), b3, voffB); PG8_STAGE(PG8_SB(1, 1), b3 + hstepB, voffB); PG8_STAGE(PG8_SA(1, 0), a3, voffA);
            PG8_WAIT_V(8); PG8_WAIT_L(0); PG8_BAR; PG8_MMA(1, 0, At, B0); PG8_MMA(1, 1, At, B1); PG8_BAR; PG8_SCHED;
        }
        if (wr == 0) PG8_BAR;
        if (!(S.dup && !(ui & 1))) E(acc, cur, wr, wc, fr, fq);
        if (!has_next) break;
#pragma unroll
        for (int a = 0; a < 2; ++a)
#pragma unroll
            for (int b = 0; b < 2; ++b)
#pragma unroll
                for (int m = 0; m < 4; ++m)
#pragma unroll
                    for (int n = 0; n < 2; ++n) acc[a][b][m][n] = (f32x4){0.f, 0.f, 0.f, 0.f};
        cur = nxt; cA = nA; cB = nB; ++ui;
        if (wr == 1) PG8_BAR;
    }
    post();
    PG8_WAIT_V(0);
    PG8_BAR;
#undef PG8_SA
#undef PG8_SB
#undef PG8_STAGE
#undef PG8_LDA
#undef PG8_LDB
#undef PG8_MMA
#undef PG8_WAIT_V
#undef PG8_WAIT_L
#undef PG8_BAR
#undef PG8_SCHED
}
}

#define LDS_WAIT() asm volatile("s_waitcnt lgkmcnt(0)" ::: "memory")
#define VM_WAIT() asm volatile("s_waitcnt vmcnt(0)" ::: "memory")
__device__ __forceinline__ h4 cvt_h4(f32x4 v) { const h2 a = __builtin_convertvector((f32x2){v.x, v.y}, h2), b = __builtin_convertvector((f32x2){v.z, v.w}, h2); return (h4){a.x, a.y, b.x, b.y}; }
__device__ __forceinline__ f32x4 cvt_f4(h4 v) { return (f32x4){(float)v.x, (float)v.y, (float)v.z, (float)v.w}; }
__device__ __forceinline__ float rcpf(float x) { return __builtin_amdgcn_rcpf(x); }
__device__ __forceinline__ float sigmoidf_(float z) { return rcpf(1.0f + __expf(-z)); }
__device__ __forceinline__ float gelu_tanh(float x) { const float t = __builtin_fmaf(x * x, -0.10294324f, -2.3022082f); return x * rcpf(1.0f + __builtin_amdgcn_exp2f(x * t)); }
__device__ __forceinline__ int hw_lane() { int l; asm volatile("v_mbcnt_lo_u32_b32 %0, -1, 0\n\tv_mbcnt_hi_u32_b32 %0, -1, %0" : "=v"(l)); return l; }
__device__ __forceinline__ int opq_tid_(int wave) { int t = wave * 64 + hw_lane(); asm volatile("" : "+v"(t)); return t; }
#define opq_tid() opq_tid_(C.wave)
__device__ __forceinline__ float wave_sum(float v) {
#pragma unroll
    for (int o = 1; o < 64; o <<= 1) v += __shfl_xor(v, o);
    return v;
}

#define XB_TMO      128
#define XB_XCNT(j)  (256  + 64 * (j))
#define XB_XSUB(j)  (1280 + 64 * (j))
#define XB_XGEN(j)  (2304 + 64 * (j))
#define XB_TOP      3328
#define XB_TOPGEN   3392
#define XCD_BAR_WORDS 3456
#define XB_SPIN_CAP (1u << 18)
__device__ __forceinline__ unsigned xb_ld(unsigned* p)              { return __hip_atomic_load(p, __ATOMIC_RELAXED, __HIP_MEMORY_SCOPE_AGENT); }
__device__ __forceinline__ unsigned xb_add(unsigned* p, unsigned v) { return __hip_atomic_fetch_add(p, v, __ATOMIC_RELAXED, __HIP_MEMORY_SCOPE_AGENT); }
__device__ __forceinline__ unsigned xb_xcc_id() { return (unsigned)__builtin_amdgcn_s_getreg((3 << 11) | 20) & 0xFu; }
#define XB_SPIN(cond, bar) do { unsigned _sp = 0; while (cond) { __builtin_amdgcn_s_sleep(1); \
    if ((++_sp & 255u) == 0u) { if (xb_ld(&(bar)[XB_TMO])) break; if (_sp > XB_SPIN_CAP) { atomicAdd(&(bar)[XB_TMO], 1u); break; } } } } while (0)
struct XcdBarrier { unsigned* bar; unsigned x; volatile LAS unsigned* st; bool w0; };
__device__ __forceinline__ XcdBarrier xcd_barrier_post(unsigned* bar, volatile LAS unsigned* st, bool w0) {
    XcdBarrier b; b.bar = bar; b.x = xb_xcc_id(); b.st = st; b.w0 = w0;
    if (w0 && hw_lane() == 0) (void)xb_add(&bar[XB_XCNT(b.x)], 1u);
    return b;
}
__device__ __forceinline__ void xcd_barrier_complete(unsigned* bar, unsigned x, unsigned& nloc, unsigned& nx) {
    const unsigned G = gridDim.x * gridDim.y * gridDim.z;
    unsigned sum, cnt, mine, sp = 0u;
    for (;;) {
        sum = 0u; cnt = 0u; mine = 0u;
#pragma unroll
        for (unsigned j = 0; j < 16; ++j) { const unsigned c = xb_ld(&bar[XB_XCNT(j)]); sum += c; cnt += (c > 0u) ? 1u : 0u; mine = (j == x) ? c : mine; }
        if (sum == G) break;
        __builtin_amdgcn_s_sleep(1);
        if ((++sp & 255u) == 0u) { if (xb_ld(&bar[XB_TMO])) break; if (sp > XB_SPIN_CAP) { atomicAdd(&bar[XB_TMO], 1u); break; } }
    }
    nloc = mine > 0u ? mine : 1u; nx = cnt > 0u ? cnt : 1u;
}
__device__ __forceinline__ void xcd_barrier(const XcdBarrier& b) {
    asm volatile("s_waitcnt vmcnt(0)" ::: "memory");
    __syncthreads();
    if (b.w0 && hw_lane() == 0) {
        unsigned* bar = b.bar;
        __builtin_amdgcn_s_waitcnt(0);
        unsigned nloc = b.st[0], nx = b.st[1];
        if (nloc == 0u) { xcd_barrier_complete(bar, b.x, nloc, nx); b.st[0] = nloc; b.st[1] = nx; }
        const unsigned old = xb_add(&bar[XB_XSUB(b.x)], 1u);
        const unsigned gen = old / nloc;
        if (old + 1u == (gen + 1u) * nloc) {
            __builtin_amdgcn_fence(__ATOMIC_RELEASE, "agent");
            asm volatile("s_waitcnt vmcnt(0)" ::: "memory");
            const unsigned og = xb_add(&bar[XB_TOP], 1u);
            const unsigned tg = og / nx;
            if (og + 1u == (tg + 1u) * nx) xb_add(&bar[XB_TOPGEN], 1u);
            else XB_SPIN(xb_ld(&bar[XB_TOPGEN]) == tg, bar);
            __builtin_amdgcn_fence(__ATOMIC_ACQUIRE, "agent");
            xb_add(&bar[XB_XGEN(b.x)], 1u);
            asm volatile("s_waitcnt vmcnt(0)" ::: "memory");
        } else {
            XB_SPIN(xb_ld(&bar[XB_XGEN(b.x)]) == gen, bar);
            __builtin_amdgcn_fence(__ATOMIC_ACQUIRE, "agent");
            asm volatile("s_waitcnt vmcnt(0)" ::: "memory");
        }
    }
    __syncthreads();
}

struct Args { const float* in[29]; float* out; unsigned char* ws; int ph_lo, ph_hi; };
struct Ctx {
    LAS unsigned char* lds;
    int G, bid, wave;
    const float* const* in; GAS float* out; GAS unsigned char* ws;
};
#define WSP(T, off) ((T*)(GAS T*)(C.ws + (off)))
__device__ __forceinline__ const float* inp_(const float* const* in, int k) { asm volatile("" : "+s"(k)); return (const float*)(const GAS float*)in[k]; }
#define INP(k) inp_(C.in, (k))
#define OUTP ((float*)C.out)
__device__ __forceinline__ bool fresh(Ctx& C) { asm volatile("" : "+s"(C.ws), "+s"(C.out)); return true; }

__device__ __forceinline__ void row_bt(int row, bool& smp, int& b, int& t) { smp = row >= MP; if (!smp) { b = row >> 12; t = row & (SEQ - 1); } else { const int r = row - MP; b = r >> 2; t = r & 3; } }
__device__ __forceinline__ float row_rinv(const float* ss, int row) {
    const f32x4* p = (const f32x4*)(ss + (size_t)row * 16); const f32x4 a = p[0], b = p[1], c = p[2], d = p[3];
    const float s = ((a.x + a.y) + (a.z + a.w)) + ((b.x + b.y) + (b.z + b.w)) + ((c.x + c.y) + (c.z + c.w)) + ((d.x + d.y) + (d.z + d.w));
    return __builtin_amdgcn_rsqf(s * (1.0f / D) + EPS);
}

struct EpiIn {
    static constexpr bool RINV = true, SUMSQ = false, FENCE_QUAD = false; static constexpr int FENCE_ROWS = 1;
    const float* ss; float* ss_out; f16* gg; f16* xb; float* pconv; float* sconv;
    __device__ __forceinline__ float quad(int row, int col, f32x4 v, float rinv) const {
        v *= rinv;
        if (col < D) { f32x4 g; g.x = gelu_tanh(v.x); g.y = gelu_tanh(v.y); g.z = gelu_tanh(v.z); g.w = gelu_tanh(v.w); *(h4*)(gg + (size_t)row * D + col) = cvt_h4(g); }
        else { const int c = col - D; *(h4*)(xb + (size_t)row * D + c) = cvt_h4(v);
            bool smp; int b, t; row_bt(row, smp, b, t);
            if (!smp) { if (t >= SEQ - 3) *(f32x4*)(pconv + ((size_t)b * 3 + (t - (SEQ - 3))) * D + c) = v; }
            else { if (t >= 1) *(f32x4*)(sconv + ((size_t)b * 3 + (t - 1)) * D + c) = v; } }
        return 0.f;
    }
};
struct EpiGate {
    static constexpr bool RINV = false, SUMSQ = false, FENCE_QUAD = true; static constexpr int FENCE_ROWS = 1;
    const float* ss; float* ss_out; const float* rb; const float* ib; const float* lam; const f16* xc; float* la; float* ix;
    __device__ __forceinline__ float quad(int row, int col, f32x4 v, float) const {
        const int blk = col >> 9, ri = (col >> 8) & 1, ch = blk * 256 + (col & 255);
        if (ri == 0) { const f32x4 bb = *(const f32x4*)(rb + ch), lm = *(const f32x4*)(lam + ch); f32x4 o;
            o.x = sigmoidf_(v.x + bb.x) * lm.x; o.y = sigmoidf_(v.y + bb.y) * lm.y; o.z = sigmoidf_(v.z + bb.z) * lm.z; o.w = sigmoidf_(v.w + bb.w) * lm.w;
            *(f32x4*)(la + (size_t)row * D + ch) = o; }
        else { const f32x4 bb = *(const f32x4*)(ib + ch); const f32x4 x = cvt_f4(*(const h4*)(xc + (size_t)row * D + ch)); f32x4 o;
            o.x = sigmoidf_(v.x + bb.x) * x.x; o.y = sigmoidf_(v.y + bb.y) * x.y; o.z = sigmoidf_(v.z + bb.z) * x.z; o.w = sigmoidf_(v.w + bb.w) * x.w;
            *(f32x4*)(ix + (size_t)row * D + ch) = o; }
        return 0.f;
    }
};
struct EpiRes {
    static constexpr bool RINV = false, SUMSQ = true, FENCE_QUAD = false; static constexpr int FENCE_ROWS = 8;
    const float* ss; float* ss_out; const float* xin_p; const float* xin_s; float* xout; f16* xh;
    __device__ __forceinline__ float quad(int row, int col, f32x4 v, float) const {
        f32x4 xo;
        if (xin_p) xo = *(const f32x4*)(row < MP ? xin_p + (size_t)row * D + col : xin_s + (size_t)(row - MP) * D + col);
        else xo = cvt_f4(*(const h4*)(xh + (size_t)row * D + col));
        const f32x4 xn = xo + v;
        if (xout) __builtin_nontemporal_store(xn, (f32x4*)(xout + (size_t)row * D + col)); else *(h4*)(xh + (size_t)row * D + col) = cvt_h4(xn);
        return (xn.x * xn.x + xn.y * xn.y) + (xn.z * xn.z + xn.w * xn.w);
    }
    __device__ __forceinline__ float oct(int row, int col, f32x4 v0, f32x4 v1, float) const {
        f32x4 x0, x1;
        if (xin_p) { const float* p = xin_p + (size_t)row * D + col; x0 = *(const f32x4*)p; x1 = *(const f32x4*)(p + 4); }
        else { const h8 h = *(const h8*)(xh + (size_t)row * D + col); x0 = (f32x4){(float)h[0], (float)h[1], (float)h[2], (float)h[3]}; x1 = (f32x4){(float)h[4], (float)h[5], (float)h[6], (float)h[7]}; }
        x0 += v0; x1 += v1;
        if (xout) { float* q = xout + (size_t)row * D + col; __builtin_nontemporal_store(x0, (f32x4*)q); __builtin_nontemporal_store(x1, (f32x4*)(q + 4)); }
        else { const h4 a = cvt_h4(x0), c = cvt_h4(x1); *(h8*)(xh + (size_t)row * D + col) = (h8){a.x, a.y, a.z, a.w, c.x, c.y, c.z, c.w}; }
        return ((x0.x * x0.x + x0.y * x0.y) + (x0.z * x0.z + x0.w * x0.w)) + ((x1.x * x1.x + x1.y * x1.y) + (x1.z * x1.z + x1.w * x1.w));
    }
};
struct EpiUp {
    static constexpr bool RINV = true, SUMSQ = false, FENCE_QUAD = false; static constexpr int FENCE_ROWS = 1;
    const float* ss; float* ss_out; f16* g; f16* v; float* pffn; float* sffn;
    __device__ __forceinline__ float quad(int row, int col, f32x4 a, float rinv) const {
        a *= rinv;
        if (col < DFF) { *(h4*)(g + (size_t)row * DFF + col) = cvt_h4(a);
            bool smp; int b, t; row_bt(row, smp, b, t);
            if (!smp) { if (t >= SEQ - 2) *(f32x4*)(pffn + ((size_t)b * 2 + (t - (SEQ - 2))) * DFF + col) = a; }
            else { if (t >= 2) *(f32x4*)(sffn + ((size_t)b * 2 + (t - 2)) * DFF + col) = a; } }
        else *(h4*)(v + (size_t)row * DFF + (col - DFF)) = cvt_h4(a);
        return 0.f;
    }
};
struct EpiRaw {
    static constexpr bool RINV = true, SUMSQ = false, FENCE_QUAD = false; static constexpr int FENCE_ROWS = 1;
    const float* ss; float* ss_out; float* raw; int ld;
    __device__ __forceinline__ float quad(int row, int col, f32x4 a, float rinv) const { *(f32x4*)(raw + (size_t)row * ld + col) = a * rinv; return 0.f; }
};
__device__ __forceinline__ float lane_rinv(const float* ss, int row, int fq) {
    const f32x4 p = *(const f32x4*)(ss + (size_t)row * 16 + 4 * fq); float s = (p.x + p.y) + (p.z + p.w);
    s += __shfl_xor(s, 16); s += __shfl_xor(s, 32); return __builtin_amdgcn_rsqf(s * (1.0f / D) + EPS);
}
template <class E> struct Pg8Epi {
    E e;
    __device__ __forceinline__ void operator()(const f32x4 (&acc)[2][2][4][2], const pg8::Unit& u, int wr, int wc, int fr, int fq) const {
        const int row0 = u.pm * 256 + wr * 64 + fr, col0 = u.pn * 256 + wc * 32 + 8 * fq;
        f32x4 ssp[2][4];
        if (E::RINV) {
#pragma unroll
            for (int ai = 0; ai < 2; ++ai)
#pragma unroll
                for (int m = 0; m < 4; ++m) ssp[ai][m] = *(const f32x4*)(e.ss + (size_t)(row0 + ai * 128 + m * 16) * 16 + 4 * fq);
        }
#pragma unroll
        for (int ai = 0; ai < 2; ++ai)
#pragma unroll
            for (int m = 0; m < 4; ++m) {
                const int row = row0 + ai * 128 + m * 16;
                float rinv = 1.0f;
                if (E::RINV) { float sq = (ssp[ai][m].x + ssp[ai][m].y) + (ssp[ai][m].z + ssp[ai][m].w); sq += __shfl_xor(sq, 16); sq += __shfl_xor(sq, 32); rinv = __builtin_amdgcn_rsqf(sq * (1.0f / D) + EPS); }
                float s = 0.f;
#pragma unroll
                for (int bj = 0; bj < 2; ++bj)
                    s += e.oct(row, col0 + bj * 128, acc[ai][bj][m][0], acc[ai][bj][m][1], rinv);
                if (E::SUMSQ) { s += __shfl_xor(s, 16); s += __shfl_xor(s, 32); if (fq == 0) e.ss_out[(size_t)row * 16 + u.pn * 4 + wc] = s; }
                if ((m & (E::FENCE_ROWS - 1)) == E::FENCE_ROWS - 1) asm volatile("" ::: "memory");
            }
    }
};

constexpr int MINI_T_OFF = 65536;
__device__ __forceinline__ float dpp_dummy_() { return 0.f; }
template <int K> struct MiniPre { static constexpr int KS32 = K / 8 / 32, NB = KS32 < 4 ? KS32 : 4; h8 fa[NB][2], fb[NB][4]; f32x4 ssn[4]; bool valid; };
#define MINI_KOFS(s_) (NB >= 2 ? ((s_) >> 1) * 64 + 16 * lq + 8 * ((s_) & 1) : (s_) * 32 + 8 * lq)
#define MINI_LOAD(uu, k0, a, b) do { const int rb_ = (uu) & 15, x_ = (uu) >> 4; \
        const GAS f16* ap_ = (const GAS f16*)A + (size_t)(MP + 32 * rb_ + l15) * lda + me.acol(x_) + w * ks + (k0) * 32; \
        _Pragma("unroll") for (int c_ = 0; c_ < 4; ++c_) { const GAS f16* bp_ = (const GAS f16*)Bt + (size_t)(me.brow(x_, c_) + l15) * ldb + w * ks + (k0) * 32; \
            _Pragma("unroll") for (int s_ = 0; s_ < NB; ++s_) b[s_][c_] = *(const GAS h8*)(bp_ + MINI_KOFS(s_)); } \
        _Pragma("unroll") for (int s_ = 0; s_ < NB; ++s_) _Pragma("unroll") for (int r_ = 0; r_ < 2; ++r_) a[s_][r_] = *(const GAS h8*)(ap_ + (size_t)(16 * r_) * lda + MINI_KOFS(s_)); } while (0)
#define MINI_SS(uu, dst) do { if (ME::RINV) { const GAS f32x4* sp_ = (const GAS f32x4*)(me.ss + (size_t)(MP + 32 * ((uu) & 15) + prow) * 16); dst[0] = sp_[0]; dst[1] = sp_[1]; dst[2] = sp_[2]; dst[3] = sp_[3]; } } while (0)
template <class ME, int K>
__device__ __forceinline__ void mini_prefetch(Ctx& C, const f16* A, int lda, const f16* Bt, int ldb, const ME& me, MiniPre<K>& pre) {
    const int tid_o = opq_tid(), lane = tid_o & 63, w = __builtin_amdgcn_readfirstlane(tid_o >> 6), l15 = lane & 15, lq = lane >> 4, prow = tid_o >> 4;
    constexpr int ks = K / 8, KS32 = ks / 32, NB = KS32 < 4 ? KS32 : 4;
    const int u = (C.G & 7) == 0 ? (C.bid & 7) * (C.G >> 3) + (C.bid >> 3) : C.bid;
    if (u < me.nunits()) { MINI_LOAD(u, 0, pre.fa, pre.fb); MINI_SS(u, pre.ssn); pre.valid = true; }
}
template <class ME, int K> struct MiniPost { Ctx* C; const f16* A; int lda; const f16* Bt; int ldb; const ME* me; MiniPre<K>* pre;
    __device__ __forceinline__ void operator()() const { mini_prefetch<ME, K>(*C, A, lda, Bt, ldb, *me, *pre); } };
template <class ME, int K>
__device__ __forceinline__ void mini_gemm(Ctx& C, const f16* A, int lda, const f16* Bt, int ldb, const ME& me, const MiniPre<K>* pre = nullptr) {
    const int tid_o = opq_tid(), lane_o = tid_o & 63, wave_o = __builtin_amdgcn_readfirstlane(tid_o >> 6);
    LAS float* P = (LAS float*)C.lds;
    LAS float* T = (LAS float*)(C.lds + MINI_T_OFF);
    constexpr int ks = K / 8, KS32 = ks / 32, NB = KS32 < 4 ? KS32 : 4;
    const int lane = lane_o, w = wave_o, nunits = me.nunits(), l15 = lane & 15, lq = lane >> 4;
    const int prow = tid_o >> 4, pcq = (tid_o & 15) * 4;
    for (int rmm = 0; rmm <= ((((REP_MASK >> 21) & 1u) && ME::IDEM) ? REP_N : 0); ++rmm) {
    int u = (C.G & 7) == 0 ? (C.bid & 7) * (C.G >> 3) + (C.bid >> 3) : C.bid;
    h8 fa[NB][2], fb[NB][4]; f32x4 ssn[4];
    if (pre && pre->valid && rmm == 0) {
#pragma unroll
        for (int s_ = 0; s_ < NB; ++s_) { fa[s_][0] = pre->fa[s_][0]; fa[s_][1] = pre->fa[s_][1]; fb[s_][0] = pre->fb[s_][0]; fb[s_][1] = pre->fb[s_][1]; fb[s_][2] = pre->fb[s_][2]; fb[s_][3] = pre->fb[s_][3]; }
        ssn[0] = pre->ssn[0]; ssn[1] = pre->ssn[1]; ssn[2] = pre->ssn[2]; ssn[3] = pre->ssn[3];
    } else if (u < nunits) { MINI_LOAD(u, 0, fa, fb); MINI_SS(u, ssn); }
    for (; u < nunits; u += C.G) {
        const int rb = u & 15, x = u >> 4, un = u + C.G;
        float rinv = 1.0f;
        f32x4 acc[2][4];
#pragma unroll
        for (int r = 0; r < 2; ++r)
#pragma unroll
            for (int c = 0; c < 4; ++c) acc[r][c] = (f32x4){0.f, 0.f, 0.f, 0.f};
#pragma unroll
        for (int sI = 0; sI < NB; ++sI)
#pragma unroll
            for (int r = 0; r < 2; ++r)
#pragma unroll
                for (int c = 0; c < 4; ++c) acc[r][c] = __builtin_amdgcn_mfma_f32_16x16x32_f16(fb[sI][c], fa[sI][r], acc[r][c], 0, 0, 0);
        if (ME::RINV) { const f32x4 q = (ssn[0] + ssn[1]) + (ssn[2] + ssn[3]); rinv = __builtin_amdgcn_rsqf(((q.x + q.y) + (q.z + q.w)) * (1.0f / D) + EPS); }
#pragma unroll
        for (int k0 = NB; k0 < KS32; k0 += NB) {
            MINI_LOAD(u, k0, fa, fb);
#pragma unroll
            for (int sI = 0; sI < NB; ++sI)
#pragma unroll
                for (int r = 0; r < 2; ++r)
#pragma unroll
                    for (int c = 0; c < 4; ++c) acc[r][c] = __builtin_amdgcn_mfma_f32_16x16x32_f16(fb[sI][c], fa[sI][r], acc[r][c], 0, 0, 0);
        }
        if (KS32 <= NB) { if (un < nunits) { MINI_LOAD(un, 0, fa, fb); MINI_SS(un, ssn); } }
#pragma unroll
        for (int r = 0; r < 2; ++r)
#pragma unroll
            for (int c = 0; c < 4; ++c) *(LAS f32x4*)(P + (w * 32 + 16 * r + l15) * 64 + 16 * c + 4 * lq) = acc[r][c];
        __syncthreads();
        {
            f32x4 v = (f32x4){0.f, 0.f, 0.f, 0.f};
#pragma unroll
            for (int ww = 0; ww < 8; ++ww) v += *(const LAS f32x4*)(P + (ww * 32 + prow) * 64 + pcq);
            if (ME::RINV) v *= rinv;
            *(LAS f32x4*)(T + prow * 64 + pcq) = v;
        }
        __syncthreads();
        me.tile(rb, x, T, tid_o);
        if (KS32 > NB) { if (un < nunits) { MINI_LOAD(un, 0, fa, fb); MINI_SS(un, ssn); } }
    }
    __syncthreads();
    }
}
#undef MINI_LOAD
#undef MINI_KOFS
#undef MINI_SS
template <class ME, int K>
__device__ __forceinline__ void mini_gemm64(Ctx& C, const f16* A, int lda, const f16* Bt, int ldb, const ME& me) {
    const int tid_o = opq_tid(), lane_o = tid_o & 63, wave_o = __builtin_amdgcn_readfirstlane(tid_o >> 6);
    LAS float* P = (LAS float*)C.lds;
    LAS float* T = (LAS float*)(C.lds + MINI_T_OFF);
    constexpr int ks = K / 4, KS32 = ks / 32, NB = KS32 < 4 ? KS32 : 4;
    const int lane = lane_o, w = wave_o, kq = w & 3, rh = w >> 2, nunits = me.nunits() >> 1, l15 = lane & 15, lq = lane >> 4;
    const int prow = tid_o >> 4, pcq = (tid_o & 15) * 4;
#define M64_KOFS(s_) (((s_) >> 1) * 64 + 16 * lq + 8 * ((s_) & 1))
#define M64_LOAD(uu, k0, a, b) do { const int rb_ = (uu) & 7, x_ = (uu) >> 3; \
        const GAS f16* ap_ = (const GAS f16*)A + (size_t)(MP + 64 * rb_ + 32 * rh + l15) * lda + me.acol(x_) + kq * ks + (k0) * 32; \
        _Pragma("unroll") for (int c_ = 0; c_ < 4; ++c_) { const GAS f16* bp_ = (const GAS f16*)Bt + (size_t)(me.brow(x_, c_) + l15) * ldb + kq * ks + (k0) * 32; \
            _Pragma("unroll") for (int s_ = 0; s_ < NB; ++s_) b[s_][c_] = *(const GAS h8*)(bp_ + M64_KOFS(s_)); } \
        _Pragma("unroll") for (int s_ = 0; s_ < NB; ++s_) _Pragma("unroll") for (int r_ = 0; r_ < 2; ++r_) a[s_][r_] = *(const GAS h8*)(ap_ + (size_t)(16 * r_) * lda + M64_KOFS(s_)); } while (0)
#define M64_SS(uu, dst) do { if (ME::RINV) { _Pragma("unroll") for (int i_ = 0; i_ < 2; ++i_) { const GAS f32x4* sp_ = (const GAS f32x4*)(me.ss + (size_t)(MP + 64 * ((uu) & 7) + 32 * i_ + prow) * 16); \
        dst[i_][0] = sp_[0]; dst[i_][1] = sp_[1]; dst[i_][2] = sp_[2]; dst[i_][3] = sp_[3]; } } } while (0)
#define M64_MMA(a, b) do { _Pragma("unroll") for (int s_ = 0; s_ < NB; ++s_) _Pragma("unroll") for (int r_ = 0; r_ < 2; ++r_) _Pragma("unroll") for (int c_ = 0; c_ < 4; ++c_) \
        acc[r_][c_] = __builtin_amdgcn_mfma_f32_16x16x32_f16(b[s_][c_], a[s_][r_], acc[r_][c_], 0, 0, 0); } while (0)
    int u = (C.G & 7) == 0 ? (C.bid & 7) * (C.G >> 3) + (C.bid >> 3) : C.bid;
    h8 fa[NB][2], fb[NB][4]; f32x4 ssn[2][4];
    if (u < nunits) { M64_LOAD(u, 0, fa, fb); M64_SS(u, ssn); }
    for (; u < nunits; u += C.G) {
        const int rb = u & 7, x = u >> 3, un = u + C.G;
        float rinv0 = 1.0f, rinv1 = 1.0f;
        f32x4 acc[2][4];
#pragma unroll
        for (int r = 0; r < 2; ++r)
#pragma unroll
            for (int c = 0; c < 4; ++c) acc[r][c] = (f32x4){0.f, 0.f, 0.f, 0.f};
        M64_MMA(fa, fb);
        if (ME::RINV) { const f32x4 q0 = (ssn[0][0] + ssn[0][1]) + (ssn[0][2] + ssn[0][3]), q1 = (ssn[1][0] + ssn[1][1]) + (ssn[1][2] + ssn[1][3]);
            rinv0 = __builtin_amdgcn_rsqf(((q0.x + q0.y) + (q0.z + q0.w)) * (1.0f / D) + EPS); rinv1 = __builtin_amdgcn_rsqf(((q1.x + q1.y) + (q1.z + q1.w)) * (1.0f / D) + EPS); }
#pragma unroll
        for (int k0 = NB; k0 < KS32; k0 += NB) { M64_LOAD(u, k0, fa, fb); M64_MMA(fa, fb); }
        if (un < nunits) { M64_LOAD(un, 0, fa, fb); M64_SS(un, ssn); }
#pragma unroll
        for (int r = 0; r < 2; ++r)
#pragma unroll
            for (int c = 0; c < 4; ++c) *(LAS f32x4*)(P + (w * 32 + 16 * r + l15) * 64 + 16 * c + 4 * lq) = acc[r][c];
        __syncthreads();
#pragma unroll
        for (int i = 0; i < 2; ++i) {
            f32x4 v = (f32x4){0.f, 0.f, 0.f, 0.f};
#pragma unroll
            for (int q4 = 0; q4 < 4; ++q4) v += *(const LAS f32x4*)(P + ((4 * i + q4) * 32 + prow) * 64 + pcq);
            if (ME::RINV) v *= (i == 0 ? rinv0 : rinv1);
            *(LAS f32x4*)(T + (32 * i + prow) * 64 + pcq) = v;
        }
        __syncthreads();
        me.tile(2 * rb, x, T, tid_o); me.tile(2 * rb + 1, x, T + 32 * 64, tid_o);
    }
    __syncthreads();
#undef M64_KOFS
#undef M64_LOAD
#undef M64_SS
#undef M64_MMA
}
template <class E> struct MiniQuad {
    static constexpr bool RINV = E::RINV, IDEM = !E::SUMSQ;
    const float* ss; E e; int N; int a_pn_bytes;
    __device__ __forceinline__ int nunits() const { return 16 * (N / 64); }
    __device__ __forceinline__ int acol(int x) const { return ((x * 64) >> 9) * (a_pn_bytes >> 1); }
    __device__ __forceinline__ int brow(int x, int c) const { return 64 * x + 16 * c; }
    __device__ __forceinline__ void tile(int rb, int x, LAS float* T, int tid) const {
        const int row = tid >> 4, cq = (tid & 15) * 4;
        const f32x4 v = *(const LAS f32x4*)(T + row * 64 + cq);
        const int grow = MP + 32 * rb + row;
        float s = e.quad(grow, 64 * x + cq, v, 1.0f);
        if (E::SUMSQ) { s += __shfl_xor(s, 1); s += __shfl_xor(s, 2); s += __shfl_xor(s, 4); s += __shfl_xor(s, 8); if ((tid & 15) == 0) e.ss_out[(size_t)grow * 16 + x] = s; }
    }
};

constexpr int DUMP_OFF = LDS_BYTES - 2048;
__device__ __forceinline__ void warm_panel(Ctx& C, const void* p, size_t bytes) {
    const int tid = opq_tid();
    const size_t nl = bytes >> 7, step = (size_t)C.G * (NWAVES * 64);
    for (size_t l0 = (size_t)C.bid * (NWAVES * 64); l0 < nl; l0 += step) {
        size_t l = l0 + tid; if (l >= nl) l = nl - 1;
        __builtin_amdgcn_global_load_lds((const unsigned*)((const char*)p + (l << 7)), (LAS unsigned*)(C.lds + DUMP_OFF + C.wave * 256), 4, 0, 0);
    }
}
template <class E, int K>
__device__ __forceinline__ void gemm_both(Ctx& C, const f16* A, int lda, const f16* Bt, int ldb, int N, int a_pn_bytes, const E& e, const E& edry, const void* warm = nullptr, size_t warm_bytes = 0) {
    pg8::Gemm g{A, Bt, lda, ldb, MP, N, K, a_pn_bytes, C.wave}; pg8::StaticOrder S; S.init(MP, N, C.G, C.bid);
    Pg8Epi<E> pe{e};
    MiniQuad<E> me0{e.ss, e, N, a_pn_bytes}; MiniPre<K> pre; pre.valid = false;
    MiniPost<MiniQuad<E>, K> post{&C, A, lda, Bt, ldb, &me0, &pre};
    pg8::gemm_phase<Pg8Epi<E>, MiniPost<MiniQuad<E>, K>>(C.lds, g, S, pe, post);
    VM_WAIT(); __syncthreads();
    if (warm) warm_panel(C, warm, warm_bytes);
    for (int rm = 0; rm <= (((REP_MASK >> 20) & 1u) ? REP_N : 0); ++rm) { MiniQuad<E> me{e.ss, rm == 0 ? e : edry, N, a_pn_bytes}; mini_gemm<MiniQuad<E>, K>(C, A, lda, Bt, ldb, me, rm == 0 ? &pre : nullptr); }
}

__device__ __forceinline__ float dpp_ror1(float v) { return __builtin_bit_cast(float, __builtin_amdgcn_update_dpp(0, __builtin_bit_cast(int, v), 0x121, 0xf, 0xf, false)); }
__device__ __forceinline__ float dpp_ror2(float v) { return __builtin_bit_cast(float, __builtin_amdgcn_update_dpp(0, __builtin_bit_cast(int, v), 0x122, 0xf, 0xf, false)); }
__device__ __forceinline__ float dpp_ror3(float v) { return __builtin_bit_cast(float, __builtin_amdgcn_update_dpp(0, __builtin_bit_cast(int, v), 0x123, 0xf, 0xf, false)); }
__device__ __forceinline__ f32x4 ror1(f32x4 v) { return (f32x4){dpp_ror1(v.x), dpp_ror1(v.y), dpp_ror1(v.z), dpp_ror1(v.w)}; }
__device__ __forceinline__ f32x4 ror2(f32x4 v) { return (f32x4){dpp_ror2(v.x), dpp_ror2(v.y), dpp_ror2(v.z), dpp_ror2(v.w)}; }
__device__ __forceinline__ f32x4 ror3(f32x4 v) { return (f32x4){dpp_ror3(v.x), dpp_ror3(v.y), dpp_ror3(v.z), dpp_ror3(v.w)}; }
__device__ __forceinline__ f32x4 sel4(bool c, f32x4 a, f32x4 b) { return (f32x4){c ? a.x : b.x, c ? a.y : b.y, c ? a.z : b.z, c ? a.w : b.w}; }
template <int K> __device__ __forceinline__ float dppf_ror(float v) { return __builtin_bit_cast(float, __builtin_amdgcn_update_dpp(0, __builtin_bit_cast(int, v), 0x120 + K, 0xf, 0xf, true)); }
template <int K> __device__ __forceinline__ float dppf_shr_old(float old, float v) { return __builtin_bit_cast(float, __builtin_amdgcn_update_dpp(__builtin_bit_cast(int, old), __builtin_bit_cast(int, v), 0x110 + K, 0xf, 0xf, false)); }
template <int K> __device__ __forceinline__ f32x4 tap_prev(f32x4 gprev, f32x4 g) {
    return (f32x4){dppf_shr_old<K>(dppf_ror<K>(gprev.x), g.x), dppf_shr_old<K>(dppf_ror<K>(gprev.y), g.y), dppf_shr_old<K>(dppf_ror<K>(gprev.z), g.z), dppf_shr_old<K>(dppf_ror<K>(gprev.w), g.w)}; }
template <int K> __device__ __forceinline__ f32x4 tap_first(f32x4 halo_lanes, f32x4 g) {
    return (f32x4){dppf_shr_old<K>(halo_lanes.x, g.x), dppf_shr_old<K>(halo_lanes.y, g.y), dppf_shr_old<K>(halo_lanes.z, g.z), dppf_shr_old<K>(halo_lanes.w, g.w)}; }
struct EpiGeglu {
    const float* ss; const float* cw; const float* cb; f16* mid; float* sidef; float* sidel; float* pffn; LAS float* H;
    __device__ __forceinline__ void operator()(f32x4 (&acc)[2][2][4][2], const pg8::Unit& u, int wr, int wc, int fr, int fq) const {
        const int ch0 = 128 * u.pn + 32 * wc + 8 * fq, rowb = u.pm * 256 + wr * 64 + fr;
        const bool seq_first = (u.pm & 15) == 0, seq_last = (u.pm & 15) == 15;
        f32x4 ssp[2][4], w0[2], w1[2], w2[2], bb[2];
#pragma unroll
        for (int ai = 0; ai < 2; ++ai)
#pragma unroll
            for (int m = 0; m < 4; ++m) ssp[ai][m] = *(const f32x4*)(ss + (size_t)(rowb + ai * 128 + m * 16) * 16 + 4 * fq);
#pragma unroll
        for (int n = 0; n < 2; ++n) { w0[n] = *(const f32x4*)(cw + ch0 + 4 * n); w1[n] = *(const f32x4*)(cw + DFF + ch0 + 4 * n); w2[n] = *(const f32x4*)(cw + 2 * DFF + ch0 + 4 * n); bb[n] = *(const f32x4*)(cb + ch0 + 4 * n); }
#pragma unroll
        for (int ai = 0; ai < 2; ++ai)
#pragma unroll
            for (int m = 0; m < 4; ++m) {
                float sq = (ssp[ai][m].x + ssp[ai][m].y) + (ssp[ai][m].z + ssp[ai][m].w); sq += __shfl_xor(sq, 16); sq += __shfl_xor(sq, 32);
                const float rinv = __builtin_amdgcn_rsqf(sq * (1.0f / D) + EPS);
#pragma unroll
                for (int n = 0; n < 2; ++n) { acc[ai][0][m][n] *= rinv; acc[ai][1][m][n] *= rinv; }
            }
        if (fr >= 14) {
#pragma unroll
            for (int ai = 0; ai < 2; ++ai)
#pragma unroll
                for (int n = 0; n < 2; ++n) *(LAS f32x4*)(H + ((wc * 4 + (2 * ai + wr)) * 2 + (fr - 14)) * 32 + 4 * n + 8 * fq) = acc[ai][0][3][n];
            if (wr == 1) {
#pragma unroll
                for (int n = 0; n < 2; ++n) { float* dst = seq_last ? pffn + ((size_t)(u.pm >> 4) * 2 + (fr - 14)) * DFF : sidel + ((size_t)u.pm * 2 + (fr - 14)) * DFF; *(f32x4*)(dst + ch0 + 4 * n) = acc[1][0][3][n]; }
            }
        }
        if (!seq_first && wr == 0 && fr < 2) {
#pragma unroll
            for (int n = 0; n < 2; ++n) { float* dst = sidef + ((size_t)u.pm * 2 + fr) * (2 * DFF) + ch0 + 4 * n; *(f32x4*)dst = acc[0][0][0][n]; *(f32x4*)(dst + DFF) = acc[0][1][0][n]; }
        }
        asm volatile("s_waitcnt lgkmcnt(0)" ::: "memory"); __builtin_amdgcn_s_barrier(); asm volatile("" ::: "memory");
#pragma unroll
        for (int ai = 0; ai < 2; ++ai) {
            const int grp = 2 * ai + wr;
            f32x4 hl1[2], hl2[2];
#pragma unroll
            for (int n = 0; n < 2; ++n) {
                f32x4 h1 = (f32x4){0.f, 0.f, 0.f, 0.f}, h2 = h1;
                if (grp > 0 && fr < 2) { const LAS float* hp = H + ((wc * 4 + grp - 1) * 2) * 32 + 4 * n + 8 * fq; h2 = *(const LAS f32x4*)hp; h1 = *(const LAS f32x4*)(hp + 32); }
                hl1[n] = h1; hl2[n] = sel4(fr == 0, h2, h1);
            }
#pragma unroll
            for (int m = 0; m < 4; ++m) {
                const int row = rowb + ai * 128 + m * 16;
                const bool skip = !seq_first && grp == 0 && m == 0 && fr < 2;
                f32x4 o2[2];
#pragma unroll
                for (int n = 0; n < 2; ++n) {
                    const f32x4 g = acc[ai][0][m][n];
                    const f32x4 p1 = m == 0 ? tap_first<1>(hl1[n], g) : tap_prev<1>(acc[ai][0][m == 0 ? 0 : m - 1][n], g);
                    const f32x4 p2 = m == 0 ? tap_first<2>(hl2[n], g) : tap_prev<2>(acc[ai][0][m == 0 ? 0 : m - 1][n], g);
                    const f32x4 gc = bb[n] + w0[n] * p2 + w1[n] * p1 + w2[n] * g;
                    const f32x4 vv = acc[ai][1][m][n];
                    o2[n].x = gelu_tanh(gc.x) * vv.x; o2[n].y = gelu_tanh(gc.y) * vv.y; o2[n].z = gelu_tanh(gc.z) * vv.z; o2[n].w = gelu_tanh(gc.w) * vv.w;
                }
                if (!skip) { const h4 a = cvt_h4(o2[0]), c = cvt_h4(o2[1]); *(h8*)(mid + (size_t)row * DFF + ch0) = (h8){a.x, a.y, a.z, a.w, c.x, c.y, c.z, c.w}; }
            }
        }
    }
};
struct MiniGeglu {
    static constexpr bool RINV = true, IDEM = true;
    const float* ss; const float* cw; const float* cb; const float* st; f16* mid; float* sffn;
    __device__ __forceinline__ int nunits() const { return 16 * (DFF / 32); }
    __device__ __forceinline__ int acol(int) const { return 0; }
    __device__ __forceinline__ int brow(int x, int c) const { const int ch0 = 32 * x, r0 = 256 * (ch0 >> 7) + (ch0 & 127); return r0 + (c >> 1) * 128 + (c & 1) * 16; }
    __device__ __forceinline__ void tile(int rb, int x, LAS float* T, int tid) const {
        const int row = tid >> 4, cc = (tid & 15) * 2, srow = 32 * rb + row, b = srow >> 2, t = srow & 3, ch = 32 * x + cc;
        float o[2];
#pragma unroll
        for (int e = 0; e < 2; ++e) {
            float gc = cb[ch + e];
#pragma unroll
            for (int j = 0; j < 3; ++j) { const int tt = t - 2 + j; const float gv = tt >= 0 ? T[(row - 2 + j) * 64 + cc + e] : st[((size_t)b * 2 + (t + j)) * DFF + ch + e]; gc += cw[j * DFF + ch + e] * gv; }
            o[e] = gelu_tanh(gc) * T[row * 64 + 32 + cc + e];
            if (t >= 2) sffn[((size_t)b * 2 + (t - 2)) * DFF + ch + e] = T[row * 64 + cc + e];
        }
        const h2 hv = __builtin_convertvector((f32x2){o[0], o[1]}, h2);
        *(h2*)(mid + (size_t)(MP + srow) * DFF + ch) = hv;
    }
};
template <int K> __device__ __forceinline__ float dpp_shr(float v, float old) { return __builtin_bit_cast(float, __builtin_amdgcn_update_dpp(__builtin_bit_cast(int, old), __builtin_bit_cast(int, v), 0x110 + K, 0xf, 0xf, false)); }
template <int K> __device__ __forceinline__ float dpp_shr0(float v) { return __builtin_bit_cast(float, __builtin_amdgcn_update_dpp(0, __builtin_bit_cast(int, v), 0x110 + K, 0xf, 0xf, true)); }
__device__ __forceinline__ float bcast15(float v, int addr) { return __builtin_bit_cast(float, __builtin_amdgcn_ds_bpermute(addr, __builtin_bit_cast(int, v))); }
__device__ __forceinline__ void lru_au(float rpre, float ipre, float rbv, float ibv, float splv, float x, float& a, float& u) {
    const float la = splv * sigmoidf_(rpre + rbv); a = __expf(la);
    u = __builtin_amdgcn_sqrtf(__builtin_fmaf(-a, a, 1.0f)) * sigmoidf_(ipre + ibv) * x;
}
struct EpiScan {
    const float* rb; const float* ib; const float* spl; const f16* xc; f16* acum; f16* hloc; float* ca; float* chh; LAS float* X;
    __device__ __forceinline__ void operator()(f32x4 (&acc)[2][2][4][2], const pg8::Unit& u, int wr, int wc, int fr, int fq) const {
        const int ch0 = 128 * u.pn + 32 * wc + 8 * fq, rowb = u.pm * 256 + wr * 64 + fr;
        const int baddr = ((((fq << 4) | 15)) << 2);
        f32x4 rbv[2], ibv[2], spv[2];
#pragma unroll
        for (int n = 0; n < 2; ++n) { rbv[n] = *(const f32x4*)(rb + ch0 + 4 * n); ibv[n] = *(const f32x4*)(ib + ch0 + 4 * n); spv[n] = *(const f32x4*)(spl + ch0 + 4 * n); }
        h8 xv[2][4];
#pragma unroll
        for (int ai = 0; ai < 2; ++ai)
#pragma unroll
            for (int m = 0; m < 4; ++m) xv[ai][m] = *(const h8*)(xc + (size_t)(rowb + ai * 128 + m * 16) * D + ch0);
#pragma unroll
        for (int ai = 0; ai < 2; ++ai) {
#pragma unroll
            for (int m = 0; m < 4; ++m)
#pragma unroll
                for (int n = 0; n < 2; ++n) {
                    const f32x4 r4 = acc[ai][0][m][n], i4 = acc[ai][1][m][n]; const h8 xq = xv[ai][m];
                    const f32x4 x4 = n == 0 ? (f32x4){(float)xq[0], (float)xq[1], (float)xq[2], (float)xq[3]} : (f32x4){(float)xq[4], (float)xq[5], (float)xq[6], (float)xq[7]};
                    const f32x4 rb4 = rbv[n], ib4 = ibv[n], sp4 = spv[n];
                    float a0, a1, a2, a3, u0, u1, u2, u3;
                    lru_au(r4.x, i4.x, rb4.x, ib4.x, sp4.x, x4.x, a0, u0); lru_au(r4.y, i4.y, rb4.y, ib4.y, sp4.y, x4.y, a1, u1);
                    lru_au(r4.z, i4.z, rb4.z, ib4.z, sp4.z, x4.z, a2, u2); lru_au(r4.w, i4.w, rb4.w, ib4.w, sp4.w, x4.w, a3, u3);
                    acc[ai][0][m][n] = (f32x4){a0, a1, a2, a3}; acc[ai][1][m][n] = (f32x4){u0, u1, u2, u3};
                }
            asm volatile("" ::: "memory");
        }
#define SCAN16(av, hv) do { float as_, hs_; \
            as_ = dpp_shr<1>(av, 1.0f); hs_ = dpp_shr0<1>(hv); hv = av * hs_ + hv; av = as_ * av; \
            as_ = dpp_shr<2>(av, 1.0f); hs_ = dpp_shr0<2>(hv); hv = av * hs_ + hv; av = as_ * av; \
            as_ = dpp_shr<4>(av, 1.0f); hs_ = dpp_shr0<4>(hv); hv = av * hs_ + hv; av = as_ * av; \
            as_ = dpp_shr<8>(av, 1.0f); hs_ = dpp_shr0<8>(hv); hv = av * hs_ + hv; av = as_ * av; } while (0)
#pragma unroll
        for (int ai = 0; ai < 2; ++ai)
#pragma unroll
            for (int n = 0; n < 2; ++n)
#pragma unroll
                for (int j = 0; j < 4; j += 2) {
                    float PA0 = 1.0f, PH0 = 0.0f, PA1 = 1.0f, PH1 = 0.0f;
#pragma unroll
                    for (int m = 0; m < 4; ++m) {
                        float a0 = acc[ai][0][m][n][j], h0 = acc[ai][1][m][n][j], a1 = acc[ai][0][m][n][j + 1], h1 = acc[ai][1][m][n][j + 1];
                        SCAN16(a0, h0); SCAN16(a1, h1);
                        h0 = a0 * PH0 + h0; a0 = PA0 * a0; h1 = a1 * PH1 + h1; a1 = PA1 * a1;
                        acc[ai][0][m][n][j] = a0; acc[ai][1][m][n][j] = h0; acc[ai][0][m][n][j + 1] = a1; acc[ai][1][m][n][j + 1] = h1;
                        PA0 = bcast15(a0, baddr); PH0 = bcast15(h0, baddr); PA1 = bcast15(a1, baddr); PH1 = bcast15(h1, baddr);
                    }
                    if (fr == 0) { LAS float* xp = X + (((wc * 4 + (2 * ai + wr)) * 32) + 4 * n + 8 * fq + j) * 2; xp[0] = PA0; xp[1] = PH0; xp[2] = PA1; xp[3] = PH1; }
                }
#undef SCAN16
        asm volatile("s_waitcnt lgkmcnt(0)" ::: "memory"); __builtin_amdgcn_s_barrier(); asm volatile("" ::: "memory");
#pragma unroll
        for (int ai = 0; ai < 2; ++ai) {
            const int grp = 2 * ai + wr;
            f32x4 QA[2], QH[2];
#pragma unroll
            for (int n = 0; n < 2; ++n) {
                QA[n] = (f32x4){1.f, 1.f, 1.f, 1.f}; QH[n] = (f32x4){0.f, 0.f, 0.f, 0.f};
#pragma unroll
                for (int gp = 0; gp < 3; ++gp) {
                    const LAS float* xp = X + (((wc * 4 + gp) * 32) + 4 * n + 8 * fq) * 2;
                    const f32x4 t0 = *(const LAS f32x4*)xp, t1 = *(const LAS f32x4*)(xp + 4);
                    const bool use = gp < grp;
                    const f32x4 ga = use ? (f32x4){t0.x, t0.z, t1.x, t1.z} : (f32x4){1.f, 1.f, 1.f, 1.f}, gh = use ? (f32x4){t0.y, t0.w, t1.y, t1.w} : (f32x4){0.f, 0.f, 0.f, 0.f};
                    QH[n] = ga * QH[n] + gh; QA[n] = QA[n] * ga;
                }
            }
#pragma unroll
            for (int m = 0; m < 4; ++m) {
                f32x4 aa[2], hh2[2];
#pragma unroll
                for (int n = 0; n < 2; ++n) { const f32x4 a = acc[ai][0][m][n]; hh2[n] = a * QH[n] + acc[ai][1][m][n]; aa[n] = QA[n] * a; }
                const size_t o = (size_t)(rowb + ai * 128 + m * 16) * D + ch0;
                { const h4 a0 = cvt_h4(aa[0]), a1 = cvt_h4(aa[1]), h0 = cvt_h4(hh2[0]), h1 = cvt_h4(hh2[1]);
                  *(h8*)(acum + o) = (h8){a0.x, a0.y, a0.z, a0.w, a1.x, a1.y, a1.z, a1.w}; *(h8*)(hloc + o) = (h8){h0.x, h0.y, h0.z, h0.w, h1.x, h1.y, h1.z, h1.w}; }
                if (grp == 3 && m == 3 && fr == 15) {
#pragma unroll
                    for (int n = 0; n < 2; ++n) { *(f32x4*)(ca + (size_t)u.pm * D + ch0 + 4 * n) = aa[n]; *(f32x4*)(chh + (size_t)u.pm * D + ch0 + 4 * n) = hh2[n]; } }
            }
        }
    }
};
struct MiniScan {
    static constexpr bool RINV = false, IDEM = true;
    const float* ss; const float* rb; const float* ib; const float* spl; const f16* xc; const f16* gg; const float* h0; f16* y; float* sh;
    __device__ __forceinline__ int nunits() const { return 16 * (D / 32); }
    __device__ __forceinline__ int acol(int x) const { return ((32 * x) >> 8) * 256; }
    __device__ __forceinline__ int brow(int x, int c) const { const int ch0 = 32 * x, r0 = 256 * (ch0 >> 7) + (ch0 & 127); return r0 + (c >> 1) * 128 + (c & 1) * 16; }
    __device__ __forceinline__ void tile(int rb_, int x, LAS float* T, int tid) const {
        if (tid < 256) {
            const int sq = tid >> 5, c = tid & 31, ch = 32 * x + c, b = 8 * rb_ + sq;
            float h = h0[(size_t)b * D + ch];
            const float rbv = rb[ch], ibv = ib[ch], spv = spl[ch];
#pragma unroll
            for (int t = 0; t < 4; ++t) {
                const int row = 4 * sq + t; const size_t o = (size_t)(MP + 32 * rb_ + row) * D + ch;
                float a, uu; lru_au(T[row * 64 + c], T[row * 64 + 32 + c], rbv, ibv, spv, (float)xc[o], a, uu);
                h = a * h + uu; y[o] = (f16)(h * (float)gg[o]);
            }
            sh[(size_t)b * D + ch] = h;
        }
    }
};
__device__ __forceinline__ void y_apply(Ctx& C, int l) {
    const int tid_o = opq_tid();
    const f16* acum = WSP(f16, WS_LA); const f16* hloc = WSP(f16, WS_IX); const f16* gg = WSP(f16, WS_GG); f16* y = WSP(f16, WS_Y);
    const float* ca = WSP(float, WS_CA); const float* chh = WSP(float, WS_CH);
    LAS float* hin = (LAS float*)C.lds;
    for (int it = C.bid; it < 256; it += C.G) {
        const int pm = it >> 2, qd = it & 3, b = pm >> 4;
#pragma unroll
        for (int e = 0; e < 2; ++e) { const int ch = tid_o + 512 * e; float cav[15], chv[15]; const int np = pm - b * 16;
#pragma unroll
            for (int j = 0; j < 15; ++j) { const int jj = j < np ? b * 16 + j : b * 16; cav[j] = ca[(size_t)jj * D + ch]; chv[j] = chh[(size_t)jj * D + ch]; }
            float h = 0.f;
#pragma unroll
            for (int j = 0; j < 15; ++j) h = j < np ? cav[j] * h + chv[j] : h;
            hin[ch] = h; }
        __syncthreads();
        for (int i = tid_o; i < 64 * 128; i += 512) {
            const int row = pm * 256 + qd * 64 + (i >> 7), c8 = (i & 127) * 8; const size_t o = (size_t)row * D + c8;
            const h8 a8 = *(const h8*)(acum + o), h8v = *(const h8*)(hloc + o), g8 = *(const h8*)(gg + o);
            float hv[8]; h8 r;
#pragma unroll
            for (int e = 0; e < 8; ++e) { hv[e] = (float)a8[e] * hin[c8 + e] + (float)h8v[e]; r[e] = (f16)(hv[e] * (float)g8[e]); }
            *(h8*)(y + o) = r;
            if ((row & (SEQ - 1)) == SEQ - 1) {
#pragma unroll
                for (int e = 0; e < 8; ++e) OUTP[O_PH + ((size_t)l * BP + b) * D + c8 + e] = hv[e];
            }
        }
        __syncthreads();
    }
}

struct EpiKVQ {
    const float* ss; const float* rope; const float* kg; const float* qg; f16* kh; f16* vh; f16* qh; float* out; int mode;
    __device__ __forceinline__ void operator()(f32x4 (&acc)[2][2][4][2], const pg8::Unit& u, int wr, int wc, int fr, int fq) const {
        const int hd = 4 * u.pn + wc, rowb = u.pm * 256 + wr * 64 + fr;
        const bool isk = mode == 0 && hd < 8, isv = mode == 0 && hd >= 8 && hd < 16;
        const int qs = mode == 0 ? hd - 16 : hd, h = hd & 7;
        f32x4 ssp[2][4];
#pragma unroll
        for (int ai = 0; ai < 2; ++ai)
#pragma unroll
            for (int m = 0; m < 4; ++m) ssp[ai][m] = *(const f32x4*)(ss + (size_t)(rowb + ai * 128 + m * 16) * 16 + 4 * fq);
        f32x4 gn[2][2];
#pragma unroll
        for (int bj = 0; bj < 2; ++bj)
#pragma unroll
            for (int n = 0; n < 2; ++n) gn[bj][n] = isv ? (f32x4){1.f, 1.f, 1.f, 1.f} : *(const f32x4*)((isk ? kg : qg) + 32 * bj + 4 * n + 8 * fq);
#pragma unroll
        for (int ai = 0; ai < 2; ++ai)
#pragma unroll
            for (int m = 0; m < 4; ++m) {
                const int row = rowb + ai * 128 + m * 16; bool smp; int b, t; row_bt(row, smp, b, t);
                const int rpos = smp ? SEQ + t : t;
                float s0 = (ssp[ai][m].x + ssp[ai][m].y) + (ssp[ai][m].z + ssp[ai][m].w); s0 += __shfl_xor(s0, 16); s0 += __shfl_xor(s0, 32);
                const float rinv = __builtin_amdgcn_rsqf(s0 * (1.0f / D) + EPS);
                f32x4 v[2][2]; float sq = 0.f;
#pragma unroll
                for (int bj = 0; bj < 2; ++bj)
#pragma unroll
                    for (int n = 0; n < 2; ++n) { v[bj][n] = acc[ai][bj][m][n] * rinv; sq += (v[bj][n].x * v[bj][n].x + v[bj][n].y * v[bj][n].y) + (v[bj][n].z * v[bj][n].z + v[bj][n].w * v[bj][n].w); }
                sq += __shfl_xor(sq, 16); sq += __shfl_xor(sq, 32);
                if (!isv) {
                    const float rn = __builtin_amdgcn_rsqf(sq * (1.0f / HD) + EPS);
#pragma unroll
                    for (int bj = 0; bj < 2; ++bj)
#pragma unroll
                        for (int n = 0; n < 2; ++n) v[bj][n] = v[bj][n] * rn * gn[bj][n];
                }
                {
                    f32x4 p0, p1; p0.x = __shfl_xor(v[0][0].x, 16); p0.y = __shfl_xor(v[0][0].y, 16); p0.z = __shfl_xor(v[0][0].z, 16); p0.w = __shfl_xor(v[0][0].w, 16);
                    p1.x = __shfl_xor(v[0][1].x, 16); p1.y = __shfl_xor(v[0][1].y, 16); p1.z = __shfl_xor(v[0][1].z, 16); p1.w = __shfl_xor(v[0][1].w, 16);
                    if (!isv && fq < 2) {
                        const float* rp = rope + (size_t)rpos * 16;
                        const f32x4 c0 = *(const f32x4*)rp, c1 = *(const f32x4*)(rp + 4), s0 = *(const f32x4*)(rp + 8), s1 = *(const f32x4*)(rp + 12);
                        if (fq == 0) { v[0][0] = v[0][0] * c0 - p0 * s0; v[0][1] = v[0][1] * c1 - p1 * s1; }
                        else { v[0][0] = v[0][0] * c0 + p0 * s0; v[0][1] = v[0][1] * c1 + p1 * s1; }
                    }
                }
                if (isk || isv) {
                    f16* dst = (isk ? kh : vh) + (size_t)row * DKV + h * 64;
                    const bool cache = smp || t >= SEQ - 2048;
                    float* co = smp ? out + (isk ? O_SCK : O_SCV) + (((size_t)b * 4 + t) * NH + h) * HD : out + (isk ? O_PCK : O_PCV) + (((size_t)b * 2048 + (t - (SEQ - 2048))) * NH + h) * HD;
#pragma unroll
                    for (int bj = 0; bj < 2; ++bj) { const int dm = 32 * bj + 8 * fq; const h4 a = cvt_h4(v[bj][0]), c = cvt_h4(v[bj][1]);
                        *(h8*)(dst + dm) = (h8){a.x, a.y, a.z, a.w, c.x, c.y, c.z, c.w};
                        if (cache) { __builtin_nontemporal_store(v[bj][0], (f32x4*)(co + dm)); __builtin_nontemporal_store(v[bj][1], (f32x4*)(co + dm + 4)); } }
                } else {
                    f16* dst = qh + (size_t)row * 1536 + qs * 64;
#pragma unroll
                    for (int bj = 0; bj < 2; ++bj) { const h4 a = cvt_h4(v[bj][0] * 0.125f), c = cvt_h4(v[bj][1] * 0.125f);
                        *(h8*)(dst + 32 * bj + 8 * fq) = (h8){a.x, a.y, a.z, a.w, c.x, c.y, c.z, c.w}; }
                }
                asm volatile("" ::: "memory");
            }
    }
};
struct MiniKVQ {
    static constexpr bool RINV = true, IDEM = true;
    const float* ss; const float* rope; const float* kg; const float* qg; f16* kh; f16* vh; f16* qh; float* out; int mode;
    __device__ __forceinline__ int nunits() const { return 16 * (mode == 0 ? 40 : 24); }
    __device__ __forceinline__ int acol(int) const { return 0; }
    __device__ __forceinline__ int brow(int x, int c) const { return 256 * (x >> 2) + 32 * (x & 3) + 128 * (c >> 1) + 16 * (c & 1); }
    __device__ __forceinline__ void tile(int rb, int x, LAS float* T, int tid) const {
        const int rowl = tid >> 4, sub = tid & 15, srow = 32 * rb + rowl, b = srow >> 2, t = srow & 3;
        const bool isk = mode == 0 && x < 8, isv = mode == 0 && x >= 8 && x < 16; const int qs = mode == 0 ? x - 16 : x, h = x & 7;
        f32x4 v = *(const LAS f32x4*)(T + rowl * 64 + sub * 4);
        float s = (v.x * v.x + v.y * v.y) + (v.z * v.z + v.w * v.w);
        s += __shfl_xor(s, 1); s += __shfl_xor(s, 2); s += __shfl_xor(s, 4); s += __shfl_xor(s, 8);
        if (!isv) { const float rn = __builtin_amdgcn_rsqf(s * (1.0f / HD) + EPS); v = v * rn * *(const f32x4*)((isk ? kg : qg) + sub * 4); }
        f32x4 p; p.x = __shfl_xor(v.x, 2); p.y = __shfl_xor(v.y, 2); p.z = __shfl_xor(v.z, 2); p.w = __shfl_xor(v.w, 2);
        if (!isv && sub < 4) { const float* rp = rope + (size_t)(SEQ + t) * 16 + 4 * (sub & 1); const f32x4 cs = *(const f32x4*)rp, sn = *(const f32x4*)(rp + 8); v = sub < 2 ? v * cs - p * sn : v * cs + p * sn; }
        if (isk || isv) { *(h4*)((isk ? kh : vh) + (size_t)(MP + srow) * DKV + h * 64 + sub * 4) = cvt_h4(v); *(f32x4*)(out + (isk ? O_SCK : O_SCV) + ((size_t)srow * NH + h) * HD + sub * 4) = v; }
        else *(h4*)(qh + (size_t)(MP + srow) * 1536 + qs * 64 + sub * 4) = cvt_h4(v * 0.125f);
    }
};

struct EpiGateGelu {
    static constexpr bool RINV = true, SUMSQ = false, FENCE_QUAD = false; static constexpr int FENCE_ROWS = 1;
    const float* ss; float* ss_out; f16* gg;
    __device__ __forceinline__ float quad(int row, int col, f32x4 v, float rinv) const { v *= rinv; f32x4 g; g.x = gelu_tanh(v.x); g.y = gelu_tanh(v.y); g.z = gelu_tanh(v.z); g.w = gelu_tanh(v.w); *(h4*)(gg + (size_t)row * D + col) = cvt_h4(g); return 0.f; }
    __device__ __forceinline__ float oct(int row, int col, f32x4 v0, f32x4 v1, float rinv) const { v0 *= rinv; v1 *= rinv; f32x4 g0, g1; g0.x = gelu_tanh(v0.x); g0.y = gelu_tanh(v0.y); g0.z = gelu_tanh(v0.z); g0.w = gelu_tanh(v0.w); g1.x = gelu_tanh(v1.x); g1.y = gelu_tanh(v1.y); g1.z = gelu_tanh(v1.z); g1.w = gelu_tanh(v1.w);
        const h4 a = cvt_h4(g0), c = cvt_h4(g1); *(h8*)(gg + (size_t)row * D + col) = (h8){a.x, a.y, a.z, a.w, c.x, c.y, c.z, c.w}; return 0.f; }
};
struct EpiInConv {
    const float* ss; const float* cw; const float* cb; f16* xc; float* sidef; float* sidel; float* pconv; LAS float* H;
    __device__ __forceinline__ void operator()(f32x4 (&acc)[2][2][4][2], const pg8::Unit& u, int wr, int wc, int fr, int fq) const {
        const int rowb = u.pm * 256 + wr * 64 + fr;
        const int c0 = 256 * u.pn + 32 * wc + 8 * fq;
        const bool seq_first = (u.pm & 15) == 0, seq_last = (u.pm & 15) == 15;
        f32x4 ssp[2][4];
#pragma unroll
        for (int ai = 0; ai < 2; ++ai)
#pragma unroll
            for (int m = 0; m < 4; ++m) ssp[ai][m] = *(const f32x4*)(ss + (size_t)(rowb + ai * 128 + m * 16) * 16 + 4 * fq);
#pragma unroll
        for (int ai = 0; ai < 2; ++ai)
#pragma unroll
            for (int m = 0; m < 4; ++m) {
                float sq = (ssp[ai][m].x + ssp[ai][m].y) + (ssp[ai][m].z + ssp[ai][m].w); sq += __shfl_xor(sq, 16); sq += __shfl_xor(sq, 32);
                const float rinv = __builtin_amdgcn_rsqf(sq * (1.0f / D) + EPS);
#pragma unroll
                for (int bj = 0; bj < 2; ++bj)
#pragma unroll
                    for (int n = 0; n < 2; ++n) acc[ai][bj][m][n] *= rinv;
            }
        if (fr >= 13) {
#pragma unroll
            for (int ai = 0; ai < 2; ++ai)
#pragma unroll
                for (int bj = 0; bj < 2; ++bj)
#pragma unroll
                    for (int n = 0; n < 2; ++n) *(LAS f32x4*)(H + ((wc * 4 + (2 * ai + wr)) * 3 + (fr - 13)) * 64 + 32 * bj + 4 * n + 8 * fq) = acc[ai][bj][3][n];
            if (wr == 1) {
                float* dst = seq_last ? pconv + ((size_t)(u.pm >> 4) * 3 + (fr - 13)) * D : sidel + ((size_t)u.pm * 3 + (fr - 13)) * D;
#pragma unroll
                for (int bj = 0; bj < 2; ++bj)
#pragma unroll
                    for (int n = 0; n < 2; ++n) *(f32x4*)(dst + c0 + 128 * bj + 4 * n) = acc[1][bj][3][n];
            }
        }
        if (!seq_first && wr == 0 && fr < 3) {
#pragma unroll
            for (int bj = 0; bj < 2; ++bj)
#pragma unroll
                for (int n = 0; n < 2; ++n) *(f32x4*)(sidef + ((size_t)u.pm * 3 + fr) * D + c0 + 128 * bj + 4 * n) = acc[0][bj][0][n];
        }
        asm volatile("s_waitcnt lgkmcnt(0)" ::: "memory"); __builtin_amdgcn_s_barrier(); asm volatile("" ::: "memory");
#pragma unroll
        for (int bj = 0; bj < 2; ++bj) {
            f32x4 W0[2], W1[2], W2[2], W3[2], BB[2];
#pragma unroll
            for (int n = 0; n < 2; ++n) { const int ch = c0 + 128 * bj + 4 * n; W0[n] = *(const f32x4*)(cw + ch); W1[n] = *(const f32x4*)(cw + D + ch); W2[n] = *(const f32x4*)(cw + 2 * D + ch); W3[n] = *(const f32x4*)(cw + 3 * D + ch); BB[n] = *(const f32x4*)(cb + ch); }
#pragma unroll
            for (int n = 0; n < 2; ++n) {
                const int ch = c0 + 128 * bj + 4 * n;
                const f32x4 w0 = W0[n], w1 = W1[n], w2 = W2[n], w3 = W3[n], bb = BB[n];
#pragma unroll
                for (int ai = 0; ai < 2; ++ai) {
                    const int grp = 2 * ai + wr;
                    f32x4 h1 = (f32x4){0.f, 0.f, 0.f, 0.f}, h2 = h1, h3 = h1;
                    if (grp > 0 && fr < 3) { const LAS float* hp = H + ((wc * 4 + grp - 1) * 3) * 64 + 32 * bj + 4 * n + 8 * fq; h3 = *(const LAS f32x4*)hp; h2 = *(const LAS f32x4*)(hp + 64); h1 = *(const LAS f32x4*)(hp + 128); }
                    const f32x4 hl1 = h1, hl2 = sel4(fr == 0, h2, h1), hl3 = sel4(fr == 0, h3, sel4(fr == 1, h2, h1));
#pragma unroll
                    for (int m = 0; m < 4; ++m) {
                        const f32x4 x = acc[ai][bj][m][n], xp = acc[ai][bj][m == 0 ? 0 : m - 1][n];
                        const f32x4 p1 = m == 0 ? tap_first<1>(hl1, x) : tap_prev<1>(xp, x), p2 = m == 0 ? tap_first<2>(hl2, x) : tap_prev<2>(xp, x), p3 = m == 0 ? tap_first<3>(hl3, x) : tap_prev<3>(xp, x);
                        const f32x4 o = bb + w0 * p3 + w1 * p2 + w2 * p1 + w3 * x;
                        const bool skip = !seq_first && grp == 0 && m == 0 && fr < 3;
                        if (!skip) *(h4*)(xc + (size_t)(rowb + ai * 128 + m * 16) * D + ch) = cvt_h4(o);
                    }
                }
            }
            asm volatile("" ::: "memory");
        }
    }
};
struct MiniInConv {
    static constexpr bool RINV = true, IDEM = true;
    const float* ss; const float* cw; const float* cb; const float* st; f16* gg; f16* xc; float* sconv;
    __device__ __forceinline__ int nunits() const { return 16 * 32; }
    __device__ __forceinline__ int acol(int) const { return 0; }
    __device__ __forceinline__ int brow(int x, int c) const { return 64 * x + 16 * c; }
    __device__ __forceinline__ void tile(int rb, int x, LAS float* T, int tid) const {
        const int rowl = tid >> 4, cq = (tid & 15) * 4, srow = 32 * rb + rowl, b = srow >> 2, t = srow & 3;
        const f32x4 v = *(const LAS f32x4*)(T + rowl * 64 + cq);
        if (x < 16) { f32x4 g; g.x = gelu_tanh(v.x); g.y = gelu_tanh(v.y); g.z = gelu_tanh(v.z); g.w = gelu_tanh(v.w); *(h4*)(gg + (size_t)(MP + srow) * D + 64 * x + cq) = cvt_h4(g); return; }
        const int ch = 64 * (x - 16) + cq;
        f32x4 o = *(const f32x4*)(cb + ch);
#pragma unroll
        for (int j = 0; j < 4; ++j) { const int tt = t - 3 + j; const f32x4 xv = tt >= 0 ? *(const LAS f32x4*)(T + (rowl - 3 + j) * 64 + cq) : *(const f32x4*)(st + ((size_t)b * 3 + (t + j)) * D + ch); o += *(const f32x4*)(cw + j * D + ch) * xv; }
        *(h4*)(xc + (size_t)(MP + srow) * D + ch) = cvt_h4(o);
        if (t >= 1) *(f32x4*)(sconv + ((size_t)b * 3 + (t - 1)) * D + ch) = v;
    }
};
__device__ __forceinline__ void g2_fixup(Ctx& C, int l, int pm, int blk) {
    const int tid_o = opq_tid();
    if ((pm & 15) != 0) {
        const float* sf = WSP(float, WS_SIDEAF) + (size_t)pm * 3 * D; const float* sl = WSP(float, WS_SIDEAL) + (size_t)(pm - 1) * 3 * D;
        const float* cw = INP(9) + (size_t)l * 4 * D; const float* cb = INP(10) + (size_t)l * D; f16* xc = WSP(f16, WS_XC) + (size_t)pm * 256 * D;
        for (int i = tid_o; i < 3 * 256; i += 512) {
            const int j = i >> 8, ch = blk * 256 + (i & 255);
            float o = cb[ch];
#pragma unroll
            for (int k = 0; k < 4; ++k) { const int rr = j - 3 + k; const float xv = rr >= 0 ? sf[(size_t)rr * D + ch] : sl[(size_t)(3 + rr) * D + ch]; o += cw[k * D + ch] * xv; }
            xc[(size_t)j * D + ch] = (f16)o;
        }
    }
}

__device__ __forceinline__ void g5_fixup(Ctx& C, int L, int pm) {
    const int tid_o = opq_tid();
    if ((pm & 15) != 0) {
        const float* sidef = WSP(float, WS_SIDEF) + (size_t)pm * 2 * (2 * DFF); const float* sidel = WSP(float, WS_SIDEL) + (size_t)(pm - 1) * 2 * DFF;
        const float* cw = INP(26) + (size_t)L * 3 * DFF; const float* cb = INP(27) + (size_t)L * DFF; f16* mid = WSP(f16, WS_MID) + (size_t)pm * 256 * DFF;
        for (int i = tid_o; i < 2 * DFF; i += 512) {
            const int j = i / DFF, ch = i - j * DFF;
            const float g0 = sidef[(size_t)j * 2 * DFF + ch], v = sidef[(size_t)j * 2 * DFF + DFF + ch];
            const float p1 = j == 0 ? sidel[DFF + ch] : sidef[ch], p2 = j == 0 ? sidel[ch] : sidel[DFF + ch];
            const float gc = cb[ch] + cw[ch] * p2 + cw[DFF + ch] * p1 + cw[2 * DFF + ch] * g0;
            mid[(size_t)j * DFF + ch] = (f16)(gelu_tanh(gc) * v);
        }
    }
    VM_WAIT(); __syncthreads();
}

__constant__ float ROPE_INV[8] = {1.0f, 0.19392274474868576f, 0.03760603093086393f, 0.007292664737217109f, 0.001414213562373095f, 0.0002742481756762073f, 5.318295896944988e-05f, 1.031338537721246e-05f};
__device__ __forceinline__ unsigned pk2h(float lo, float hi) { const h2 a = __builtin_convertvector((f32x2){lo, hi}, h2); return __builtin_bit_cast(unsigned, a); }
__device__ __forceinline__ int perm_row(int perm, int n) { if (perm == 3) { const int hd = n >> 6, dim = n & 63; return 256 * (hd >> 2) + 128 * (dim >> 5) + 32 * (hd & 3) + (dim & 31); }
    if (perm == 2) return 256 * (n >> 7) + (n & 127);
    if (perm == 1) { const int c = n < DFF ? n : n - DFF; return 256 * (c >> 7) + (c & 127) + (n < DFF ? 0 : 128); } return n; }
struct TrDesc { const float* W; f16* WT; const float* gain; int N, ldt, row_off, item, perm; };
__device__ __forceinline__ void tr_load(const TrDesc& d, int lane, f32x4 (&v)[8]) {
    const int nblk = d.N / 32, kb = d.item / nblk, nb = d.item % nblk, k0 = 64 * kb, n0 = 32 * nb;
    const GAS float* p = (const GAS float*)d.W + (size_t)(k0 + (lane >> 3)) * d.N + n0 + 4 * (lane & 7);
#pragma unroll
    for (int i = 0; i < 8; ++i) v[i] = __builtin_nontemporal_load((const GAS f32x4*)(p + (size_t)(8 * i) * d.N));
}
__device__ __forceinline__ void tr_finish(const TrDesc& d, int lane, const f32x4 (&v)[8], LAS float* scr) {
    const int nblk = d.N / 32, kb = d.item / nblk, nb = d.item % nblk, k0 = 64 * kb, n0 = 32 * nb, r0 = perm_row(d.perm, n0);
#pragma unroll
    for (int i = 0; i < 8; ++i) { LAS float* q = scr + ((lane >> 3) + 8 * i) * 33 + 4 * (lane & 7); q[0] = v[i].x; q[1] = v[i].y; q[2] = v[i].z; q[3] = v[i].w; }
    const int c = lane & 7;
    f32x4 g0 = (f32x4){1.f, 1.f, 1.f, 1.f}, g1 = g0;
    if (d.gain) { g0 = *(const f32x4*)(d.gain + k0 + 8 * c); g1 = *(const f32x4*)(d.gain + k0 + 8 * c + 4); }
    LDS_WAIT(); asm volatile("" ::: "memory");
#pragma unroll
    for (int j = 0; j < 4; ++j) { const int n = (lane >> 3) + 8 * j; const LAS float* s = scr + (8 * c) * 33 + n;
        u32x4 o; o.x = pk2h(s[0 * 33] * g0.x, s[1 * 33] * g0.y); o.y = pk2h(s[2 * 33] * g0.z, s[3 * 33] * g0.w); o.z = pk2h(s[4 * 33] * g1.x, s[5 * 33] * g1.y); o.w = pk2h(s[6 * 33] * g1.z, s[7 * 33] * g1.w);
        *(u32x4*)(d.WT + (size_t)(d.row_off + r0 + n) * d.ldt + k0 + 8 * c) = o; }
    LDS_WAIT(); asm volatile("" ::: "memory");
}
constexpr int P0_NITEMS = 2048 + 512 + 1024 + 512 + 768 + 768 + 512 + 12288 + 6144;
__device__ __forceinline__ TrDesc tr_lookup(Ctx& C, int it) {
    int r = it;
    if (r < 2048) { const int l = r >> 10; return TrDesc{INP(8) + (size_t)l * D * 2048, WSP(f16, WS_WIN) + (size_t)l * 2048 * D, INP(7) + l * D, 2048, D, 0, r & 1023, 0}; } r -= 2048;
    if (r < 512) { const int l = r >> 8, rr = r & 255, blk = rr >> 6, ri = (rr >> 5) & 1, item = rr & 31;
        return TrDesc{(ri ? INP(13) : INP(11)) + ((size_t)l * 4 + blk) * 65536, WSP(f16, WS_WG) + (size_t)l * 2048 * 256, nullptr, 256, 256, blk * 512 + ri * 128, item, 2}; } r -= 512;
    if (r < 1024) { const int l = r >> 9; return TrDesc{INP(16) + (size_t)l * D * D, WSP(f16, WS_WOUT) + (size_t)l * D * D, nullptr, D, D, 0, r & 511, 0}; } r -= 1024;
    if (r < 512) return TrDesc{INP(18), WSP(f16, WS_WKVQ), INP(17), 1024, D, 0, r, 3}; r -= 512;
    if (r < 768) return TrDesc{INP(21), WSP(f16, WS_WKVQ), INP(20), 1536, D, 1024, r, 3}; r -= 768;
    if (r < 768) return TrDesc{INP(21) + (size_t)D * 1536, WSP(f16, WS_WQ1), INP(20) + D, 1536, D, 0, r, 3}; r -= 768;
    if (r < 512) { const int j = r >> 8; return TrDesc{INP(23) + (size_t)j * 512 * D, WSP(f16, WS_WO) + (size_t)j * D * 512, nullptr, D, 512, 0, r & 255, 0}; } r -= 512;
    if (r < 12288) { const int l = r / 3072; return TrDesc{INP(25) + (size_t)l * D * 6144, WSP(f16, WS_WUP) + (size_t)l * 6144 * D, INP(24) + l * D, 6144, D, 0, r % 3072, 1}; } r -= 12288;
    { const int l = r / 1536; return TrDesc{INP(28) + (size_t)l * DFF * D, WSP(f16, WS_WDN) + (size_t)l * D * DFF, nullptr, D, DFF, 0, r % 1536, 0}; }
}
constexpr int CV_A = 4864 + 6144 + 3072, CV_B = 768 + 512 + 3072 + 1536, CV_C = 3072 + 1536;
__device__ __forceinline__ int cv_map(int grp, int j) {
    if (grp == 0) { if (j < 4864) return j; j -= 4864; if (j < 6144) return 6144 + j; return 18432 + (j - 6144); }
    if (grp == 1) { if (j < 1280) return 4864 + j; j -= 1280; if (j < 3072) return 6144 + 6144 + j; return 18432 + 3072 + (j - 3072); }
    if (j < 3072) return 6144 + 9216 + j; return 18432 + 4608 + (j - 3072);
}
__device__ __forceinline__ void convert_weights(Ctx& C, int grp, int nitems, int rank, int nwg) {
    const int tid_o = opq_tid(), lane = tid_o & 63, wave_o = __builtin_amdgcn_readfirstlane(tid_o >> 6);
    LAS float* scr = (LAS float*)(C.lds + wave_o * 16384);
    const int gw = rank * NWAVES + wave_o, NGW = nwg * NWAVES;
    int it = gw; bool have = it < nitems; TrDesc d0{}; f32x4 v0[8];
    if (have) { d0 = tr_lookup(C, cv_map(grp, it)); tr_load(d0, lane, v0); }
    while (have) {
        const int itn = it + NGW; const bool haven = itn < nitems; TrDesc d1{}; f32x4 v1[8];
        if (haven) { d1 = tr_lookup(C, cv_map(grp, itn)); tr_load(d1, lane, v1); }
        tr_finish(d0, lane, v0, scr);
        if (haven) { d0 = d1;
#pragma unroll
            for (int i = 0; i < 8; ++i) v0[i] = v1[i]; }
        it = itn; have = haven;
    }
}
__device__ __forceinline__ void p0_prologue(Ctx& C) {
    const int tid_o = opq_tid(), lane_o = tid_o & 63, wave_o = __builtin_amdgcn_readfirstlane(tid_o >> 6); (void)lane_o; (void)wave_o;
    LAS float* scr = (LAS float*)(C.lds + wave_o * 16384);
    const int gw = C.bid * NWAVES + wave_o, NGW = C.G * NWAVES, lane = lane_o;
    convert_weights(C, 0, CV_A, C.bid, C.G);
    for (int i = C.bid * 512 + tid_o; i < 2 * D; i += C.G * 512) WSP(float, WS_SPL)[i] = -8.0f * log1pf(expf(-INP(15)[i]));
    for (int i = C.bid * 512 + tid_o; i < 4100 * 8; i += C.G * 512) { const int p = i >> 3, k = i & 7; const float pos = (float)(p < SEQ ? p : NPAST + (p - SEQ)), ang = pos * ROPE_INV[k];
        WSP(float, WS_ROPE)[p * 16 + k] = cosf(ang); WSP(float, WS_ROPE)[p * 16 + 8 + k] = sinf(ang); }
    f16* xh = WSP(f16, WS_XH); float* ss = WSP(float, WS_SS);
    for (int m0 = gw; m0 < M; m0 += 2 * NGW) {
        f32x4 v[2][4]; const int m1 = m0 + NGW; const bool two = m1 < M;
#pragma unroll
        for (int q = 0; q < 2; ++q) { const int m = q == 0 ? m0 : (two ? m1 : m0); const float* xrow = m < MP ? INP(0) + (size_t)m * D : INP(1) + (size_t)(m - MP) * D;
#pragma unroll
            for (int j = 0; j < 4; ++j) v[q][j] = __builtin_nontemporal_load((const f32x4*)(xrow + 4 * lane + 256 * j)); }
#pragma unroll
        for (int q = 0; q < 2; ++q) { const int m = q == 0 ? m0 : m1; if (q == 1 && !two) break;
            float s2 = 0.f;
#pragma unroll
            for (int j = 0; j < 4; ++j) { const f32x4 w = v[q][j]; s2 += (w.x * w.x + w.y * w.y) + (w.z * w.z + w.w * w.w); *(h4*)(xh + (size_t)m * D + 4 * lane + 256 * j) = cvt_h4(w); }
            s2 = wave_sum(s2);
            if (lane < 16) ss[(size_t)m * 16 + lane] = lane == 0 ? s2 : 0.f; }
    }
}

__device__ __forceinline__ void e1_conv_a(Ctx& C, int l) {
    const int tid_o = opq_tid(), lane_o = tid_o & 63, wave_o = __builtin_amdgcn_readfirstlane(tid_o >> 6); (void)lane_o; (void)wave_o;
    const f16* xb = WSP(f16, WS_XB); f16* xc = WSP(f16, WS_XC);
    const float* cw = INP(9) + (size_t)l * 4 * D; const float* cb = INP(10) + (size_t)l * D; const float* st = INP(5) + (size_t)l * BS * 3 * D;
    const size_t total = (size_t)M * (D / 8), stride = (size_t)C.G * 512;
    for (size_t it = (size_t)C.bid * 512 + tid_o; it < total; it += stride) {
        const int row = (int)(it >> 7), c = (int)(it & 127) * 8;
        bool smp; int b, t; row_bt(row, smp, b, t);
        float acc[8];
#pragma unroll
        for (int e = 0; e < 8; ++e) acc[e] = cb[c + e];
#pragma unroll
        for (int j = 0; j < 4; ++j) {
            const int tt = t - 3 + j; float xv[8];
            if (tt >= 0) { const h8 v = *(const h8*)(xb + (size_t)(row - 3 + j) * D + c);
#pragma unroll
                for (int e = 0; e < 8; ++e) xv[e] = (float)v[e]; }
            else if (smp) { const float* p = st + ((size_t)b * 3 + (t + j)) * D + c;
#pragma unroll
                for (int e = 0; e < 8; ++e) xv[e] = p[e]; }
            else {
#pragma unroll
                for (int e = 0; e < 8; ++e) xv[e] = 0.f; }
#pragma unroll
            for (int e = 0; e < 8; ++e) acc[e] += cw[j * D + c + e] * xv[e];
        }
        h8 o;
#pragma unroll
        for (int e = 0; e < 8; ++e) o[e] = (f16)acc[e];
        *(h8*)(xc + (size_t)row * D + c) = o;
    }
}
__device__ __forceinline__ void e2a_scan_carry(Ctx& C) {
    const int tid_o = opq_tid(), lane_o = tid_o & 63, wave_o = __builtin_amdgcn_readfirstlane(tid_o >> 6); (void)lane_o; (void)wave_o;
    const float* la = WSP(float, WS_LA); const float* ix = WSP(float, WS_IX); float* ca = WSP(float, WS_CA); float* chh = WSP(float, WS_CH);
    const int total = BP * 32 * D;
    for (int it = C.bid * 512 + tid_o; it < total; it += C.G * 512) {
        const int c = it & (D - 1), k = (it >> 10) & 31, b = it >> 15;
        const size_t base = ((size_t)b * SEQ + k * 128) * D + c;
        float Ap = 1.f, H = 0.f;
#pragma unroll 8
        for (int t = 0; t < 128; ++t) { const float l2 = la[base + (size_t)t * D], xi = ix[base + (size_t)t * D];
            const float a = __expf(l2), u = sqrtf(-expm1f(2.0f * l2)) * xi; Ap *= a; H = a * H + u; }
        ca[it] = Ap; chh[it] = H;
    }
}
__device__ __forceinline__ void e2b_scan_apply(Ctx& C, int l) {
    const int tid_o = opq_tid(), lane_o = tid_o & 63, wave_o = __builtin_amdgcn_readfirstlane(tid_o >> 6); (void)lane_o; (void)wave_o;
    const float* la = WSP(float, WS_LA); const float* ix = WSP(float, WS_IX); const float* ca = WSP(float, WS_CA); const float* chh = WSP(float, WS_CH);
    const f16* gg = WSP(f16, WS_GG); f16* y = WSP(f16, WS_Y);
    const int totalp = BP * 32 * D, totals = BS * D;
    for (int it = C.bid * 512 + tid_o; it < totalp + totals; it += C.G * 512) {
        if (it < totalp) {
            const int c = it & (D - 1), k = (it >> 10) & 31, b = it >> 15;
            float h = 0.f;
            for (int j = 0; j < k; ++j) { const int ci = ((b * 32 + j) << 10) + c; h = ca[ci] * h + chh[ci]; }
            const size_t base = ((size_t)b * SEQ + k * 128) * D + c;
#pragma unroll 8
            for (int t = 0; t < 128; ++t) { const size_t o = base + (size_t)t * D; const float l2 = la[o], xi = ix[o];
                const float a = __expf(l2), u = sqrtf(-expm1f(2.0f * l2)) * xi; h = a * h + u; y[o] = (f16)(h * (float)gg[o]); }
            if (k == 31) OUTP[O_PH + ((size_t)l * BP + b) * D + c] = h;
        } else {
            const int i2 = it - totalp, c = i2 & (D - 1), b = i2 >> 10;
            float h = INP(4)[((size_t)l * BS + b) * D + c];
            const size_t base = ((size_t)MP + b * 4) * D + c;
#pragma unroll
            for (int t = 0; t < 4; ++t) { const size_t o = base + (size_t)t * D; const float l2 = la[o], xi = ix[o];
                const float a = __expf(l2), u = sqrtf(-expm1f(2.0f * l2)) * xi; h = a * h + u; y[o] = (f16)(h * (float)gg[o]); }
            OUTP[O_SH + ((size_t)l * BS + b) * D + c] = h;
        }
    }
}
__device__ __forceinline__ void e3_geglu(Ctx& C, int L) {
    const int tid_o = opq_tid(), lane_o = tid_o & 63, wave_o = __builtin_amdgcn_readfirstlane(tid_o >> 6); (void)lane_o; (void)wave_o;
    const f16* g = WSP(f16, WS_G); const f16* v = WSP(f16, WS_V); f16* mid = WSP(f16, WS_MID);
    const float* cw = INP(26) + (size_t)L * 3 * DFF; const float* cb = INP(27) + (size_t)L * DFF; const float* st = INP(6) + (size_t)L * BS * 2 * DFF;
    const size_t total = (size_t)M * (DFF / 8), stride = (size_t)C.G * 512;
    for (size_t it = (size_t)C.bid * 512 + tid_o; it < total; it += stride) {
        const int row = (int)(it / 384), c = (int)(it % 384) * 8;
        bool smp; int b, t; row_bt(row, smp, b, t);
        float acc[8];
#pragma unroll
        for (int e = 0; e < 8; ++e) acc[e] = cb[c + e];
#pragma unroll
        for (int j = 0; j < 3; ++j) {
            const int tt = t - 2 + j; float xv[8];
            if (tt >= 0) { const h8 q = *(const h8*)(g + (size_t)(row - 2 + j) * DFF + c);
#pragma unroll
                for (int e = 0; e < 8; ++e) xv[e] = (float)q[e]; }
            else if (smp) { const float* p = st + ((size_t)b * 2 + (t + j)) * DFF + c;
#pragma unroll
                for (int e = 0; e < 8; ++e) xv[e] = p[e]; }
            else {
#pragma unroll
                for (int e = 0; e < 8; ++e) xv[e] = 0.f; }
#pragma unroll
            for (int e = 0; e < 8; ++e) acc[e] += cw[j * DFF + c + e] * xv[e];
        }
        const h8 vv = *(const h8*)(v + (size_t)row * DFF + c);
        h8 o;
#pragma unroll
        for (int e = 0; e < 8; ++e) o[e] = (f16)(gelu_tanh(acc[e]) * (float)vv[e]);
        *(h8*)(mid + (size_t)row * DFF + c) = o;
    }
}
__device__ __forceinline__ void e4_headnorm_rope(Ctx& C, int mode) {
    const int tid_o = opq_tid(), lane_o = tid_o & 63, wave_o = __builtin_amdgcn_readfirstlane(tid_o >> 6); (void)lane_o; (void)wave_o;
    const float* raw = WSP(float, WS_RAW); f16* kh = WSP(f16, WS_KH); f16* vh = WSP(f16, WS_VH); f16* qh = WSP(f16, WS_QH);
    const int nslot = mode == 0 ? 40 : 24, ld = mode == 0 ? 2560 : 1536, qbase = mode == 0 ? 16 : 0, jq = mode == 0 ? 0 : 1;
    const float* kg = INP(19); const float* qg = INP(22) + jq * HD;
    const size_t total = (size_t)M * nslot, stride = (size_t)C.G * 32;
    const int sub = lane_o & 15, grp = tid_o >> 4;
    for (size_t it = (size_t)C.bid * 32 + grp; it < total; it += stride) {
        const int row = (int)(it / nslot), slot = (int)(it % nslot);
        bool smp; int b, t; row_bt(row, smp, b, t);
        f32x4 v = *(const f32x4*)(raw + (size_t)row * ld + slot * 64 + sub * 4);
        const bool isv = (mode == 0) && slot >= 8 && slot < 16;
        const bool isk = (mode == 0) && slot < 8;
        float s = (v.x * v.x + v.y * v.y) + (v.z * v.z + v.w * v.w);
        s += __shfl_xor(s, 1); s += __shfl_xor(s, 2); s += __shfl_xor(s, 4); s += __shfl_xor(s, 8);
        f32x4 o = v;
        if (!isv) {
            const float rn = __builtin_amdgcn_rsqf(s * (1.0f / HD) + EPS);
            const f32x4 gv = *(const f32x4*)((isk ? kg : qg) + sub * 4);
            o = v * rn * gv;
        }
        f32x4 p; p.x = __shfl_xor(o.x, 2); p.y = __shfl_xor(o.y, 2); p.z = __shfl_xor(o.z, 2); p.w = __shfl_xor(o.w, 2);
        if (!isv && sub < 4) {
            const float pos = (float)(smp ? NPAST + t : t);
            const int i0 = (sub & 1) * 4;
            float cs[4], sn[4];
#pragma unroll
            for (int e = 0; e < 4; ++e) { const float ang = pos * ROPE_INV[i0 + e]; cs[e] = cosf(ang); sn[e] = sinf(ang); }
            if (sub < 2) { o.x = o.x * cs[0] - p.x * sn[0]; o.y = o.y * cs[1] - p.y * sn[1]; o.z = o.z * cs[2] - p.z * sn[2]; o.w = o.w * cs[3] - p.w * sn[3]; }
            else { o.x = o.x * cs[0] + p.x * sn[0]; o.y = o.y * cs[1] + p.y * sn[1]; o.z = o.z * cs[2] + p.z * sn[2]; o.w = o.w * cs[3] + p.w * sn[3]; }
        }
        if (isk || isv) {
            const int h = slot & 7; f16* dst = isk ? kh : vh;
            *(h4*)(dst + (size_t)row * DKV + h * 64 + sub * 4) = cvt_h4(o);
            unsigned co = 0u;
            if (!smp) { if (t >= SEQ - 2048) co = (unsigned)(isk ? O_PCK : O_PCV) + (unsigned)(((b * 2048 + (t - (SEQ - 2048))) * NH + h) * HD + sub * 4); }
            else co = (unsigned)(isk ? O_SCK : O_SCV) + (unsigned)(((b * 4 + t) * NH + h) * HD + sub * 4);
            if (co) *(f32x4*)(OUTP + co) = o;
        } else {
            const int qs = slot - qbase;
            *(h4*)(qh + (size_t)row * 1536 + qs * 64 + sub * 4) = cvt_h4(o * 0.125f);
        }
    }
}
__device__ __forceinline__ void e5_merge(Ctx& C) {
    const int tid_o = opq_tid(), lane_o = tid_o & 63, wave_o = __builtin_amdgcn_readfirstlane(tid_o >> 6); (void)lane_o; (void)wave_o;
    const f16* og = WSP(f16, WS_OG); const float* lse = WSP(float, WS_LSE); f16* att = WSP(f16, WS_ATT);
    const size_t total = (size_t)M * NH * 8, stride = (size_t)C.G * 512;
    for (size_t it = (size_t)C.bid * 512 + tid_o; it < total; it += stride) {
        const int sub = (int)(it & 7), h = (int)((it >> 3) & 7), row = (int)(it >> 6);
        const float l0 = lse[((size_t)0 * M + row) * NH + h], l1 = lse[((size_t)1 * M + row) * NH + h], l2 = lse[((size_t)2 * M + row) * NH + h];
        const float mx = fmaxf(l0, fmaxf(l1, l2));
        float w0 = __expf(l0 - mx), w1 = __expf(l1 - mx), w2 = __expf(l2 - mx); const float inv = 1.0f / (w0 + w1 + w2); w0 *= inv; w1 *= inv; w2 *= inv;
        const size_t o = (size_t)row * DKV + h * 64 + sub * 8;
        const h8 a = *(const h8*)(og + o), b2 = *(const h8*)(og + (size_t)M * DKV + o), c2 = *(const h8*)(og + (size_t)2 * M * DKV + o);
        h8 r;
#pragma unroll
        for (int e = 0; e < 8; ++e) r[e] = (f16)(w0 * (float)a[e] + w1 * (float)b2[e] + w2 * (float)c2[e]);
        *(h8*)(att + o) = r;
    }
}

constexpr int KV_STRIDE = 144;
constexpr int KV_ROWS = 400;
constexpr int ATT_K_OFF = 0, ATT_V_OFF = KV_ROWS * KV_STRIDE;
__device__ __forceinline__ s16x4 tr_read(LAS unsigned char* p) { return __builtin_amdgcn_ds_read_tr16_b64_v4i16((LAS s16x4*)p); }
__device__ __forceinline__ void att_prompt(Ctx& C, const int prank, const int pcnt) {
    const int tid_o = opq_tid(), lane_o = tid_o & 63, wave_o = __builtin_amdgcn_readfirstlane(tid_o >> 6); (void)lane_o; (void)wave_o;
    const f16* qh = WSP(f16, WS_QH); const f16* kh = WSP(f16, WS_KH); const f16* vh = WSP(f16, WS_VH); f16* og = WSP(f16, WS_OG); float* lse = WSP(float, WS_LSE);
    LAS unsigned char* Ks = C.lds + ATT_K_OFF; LAS unsigned char* Vs = C.lds + ATT_V_OFF;
    const int tid = tid_o, lane = lane_o, w = wave_o, l15 = lane & 15, lq = lane >> 4;
    for (int i = tid; i < 16 * KV_STRIDE / 4; i += 512) { ((LAS unsigned*)(Vs + 384 * KV_STRIDE))[i] = 0u; ((LAS unsigned*)(Ks + 384 * KV_STRIDE))[i] = 0u; }
    __syncthreads();
    constexpr int NUNITS = BP * NH * 48;
#define AU_DECODE(xx, bhh, b_, h_, g_, d_, r_, n_) const int h_ = (bhh) & 7, b_ = (bhh) >> 3, g_ = (xx) >> 4, d_ = 1 << (2 * g_), \
        r_ = g_ == 0 ? 0 : (g_ == 1 ? ((xx) - 16) >> 2 : (xx) - 32), n_ = g_ == 0 ? (xx) : (g_ == 1 ? ((xx) - 16) & 3 : 0);
#define AU_FETCH(rs, b_, h_, d_, r_, n_, dst) do { _Pragma("unroll") for (int i_ = 0; i_ < 6; ++i_) { const int ch_ = tid + 512 * i_, kk_ = ch_ >> 3, c8_ = ch_ & 7, mk_ = 256 * (n_) - 128 + kk_; \
            const unsigned vo_ = mk_ >= 0 ? (unsigned)(((b_) * SEQ + (d_) * mk_ + (r_)) * DKV + (h_) * 64 + c8_ * 8) * 2u : 0xFFFFFFF0u; \
            dst[i_] = __builtin_amdgcn_raw_buffer_load_b128(rs, (int)vo_, 0, 0); } } while (0)
#define AU_TO_LDS(base, src) do { _Pragma("unroll") for (int i_ = 0; i_ < 6; ++i_) { const int ch_ = tid + 512 * i_, kk_ = ch_ >> 3, c8_ = ch_ & 7; *(LAS u32x4*)((base) + kk_ * KV_STRIDE + c8_ * 16) = src[i_]; } } while (0)
    const __amdgpu_buffer_rsrc_t krs = __builtin_amdgcn_make_buffer_rsrc((void*)kh, 0, M * DKV * 2, 0x00020000), vrs = __builtin_amdgcn_make_buffer_rsrc((void*)vh, 0, M * DKV * 2, 0x00020000);
    u32x4 stg[6];
    const int vb0 = prank;
    int ux = vb0 % 48, ubh = vb0 / 48; const int sx = pcnt % 48, sbh = pcnt / 48;
    if (vb0 < NUNITS) { AU_DECODE(ux, ubh, pb_, ph_, pg_, pd_, pr_, pn_) (void)pg_; AU_FETCH(krs, pb_, ph_, pd_, pr_, pn_, stg); }
    for (int u = vb0; u < NUNITS; u += pcnt) {
        AU_DECODE(ux, ubh, b, h, g, d, r, n)
        AU_TO_LDS(Ks, stg);
        AU_FETCH(vrs, b, h, d, r, n, stg);
        h8 qf[2][2];
#pragma unroll
        for (int qb = 0; qb < 2; ++qb) { const size_t qrow_ = (size_t)b * SEQ + (size_t)d * (256 * n + 128 * qb + 16 * w + l15) + r;
            qf[qb][0] = *(const GAS h8*)((const GAS f16*)qh + qrow_ * 1536 + g * 512 + h * 64 + 8 * lq); qf[qb][1] = *(const GAS h8*)((const GAS f16*)qh + qrow_ * 1536 + g * 512 + h * 64 + 32 + 8 * lq); }
        __syncthreads();
        h8 pf[2][5]; float mxs[2], dens[2];
#pragma unroll
        for (int qb = 0; qb < 2; ++qb) {
            const int kb0 = 128 * qb + 16 * w, qi = kb0 + l15;
            f32x4 s[10];
#pragma unroll
            for (int bb = 0; bb < 10; ++bb) {
                const LAS unsigned char* kp = Ks + (kb0 + 16 * bb + l15) * KV_STRIDE + 16 * lq;
                const h8 k0 = *(const LAS h8*)kp, k1 = *(const LAS h8*)(kp + 64);
                f32x4 a = (f32x4){0.f, 0.f, 0.f, 0.f};
                a = __builtin_amdgcn_mfma_f32_16x16x32_f16(k0, qf[qb][0], a, 0, 0, 0);
                a = __builtin_amdgcn_mfma_f32_16x16x32_f16(k1, qf[qb][1], a, 0, 0, 0);
                s[bb] = a;
            }
            const int lo = max(0, (n == 0 ? 128 : 0) - qi), dl = 4 * lq - l15 - lo; const unsigned span = (unsigned)(128 - lo);
            float mx = -INFINITY;
#pragma unroll
            for (int bb = 0; bb < 10; ++bb)
#pragma unroll
                for (int e = 0; e < 4; ++e) { const bool ok = (unsigned)(16 * bb + e + dl) <= span;
                    s[bb][e] = ok ? s[bb][e] : -INFINITY; mx = fmaxf(mx, s[bb][e]); }
            mx = fmaxf(mx, __shfl_xor(mx, 16)); mx = fmaxf(mx, __shfl_xor(mx, 32));
            float den = 0.f;
#pragma unroll
            for (int bb = 0; bb < 10; ++bb)
#pragma unroll
                for (int e = 0; e < 4; ++e) { const float p = __expf(s[bb][e] - mx); s[bb][e] = p; den += p; }
            den += __shfl_xor(den, 16); den += __shfl_xor(den, 32);
            mxs[qb] = mx; dens[qb] = den;
#pragma unroll
            for (int c = 0; c < 5; ++c) { const h4 plo = cvt_h4(s[2 * c]), phi = cvt_h4(s[2 * c + 1]); pf[qb][c] = (h8){plo.x, plo.y, plo.z, plo.w, phi.x, phi.y, phi.z, phi.w}; }
        }
        AU_TO_LDS(Vs, stg);
        ux += sx; ubh += sbh; if (ux >= 48) { ux -= 48; ++ubh; }
        if (u + pcnt < NUNITS) { AU_DECODE(ux, ubh, nb_, nh_, ng_, nd_, nr_, nn_) (void)ng_; AU_FETCH(krs, nb_, nh_, nd_, nr_, nn_, stg); }
        __syncthreads();
#pragma unroll
        for (int qb = 0; qb < 2; ++qb) {
            const int kb0 = 128 * qb + 16 * w;
            const size_t qrow = (size_t)b * SEQ + (size_t)d * (256 * n + kb0 + l15) + r;
            f32x4 o[4];
#pragma unroll
            for (int db = 0; db < 4; ++db) o[db] = (f32x4){0.f, 0.f, 0.f, 0.f};
#pragma unroll
            for (int c = 0; c < 5; ++c) {
                const int r0 = kb0 + 32 * c + 4 * lq + (l15 >> 2);
#pragma unroll
                for (int db = 0; db < 4; ++db) {
                    const s16x4 lo = tr_read(Vs + r0 * KV_STRIDE + (16 * db + 4 * (l15 & 3)) * 2), hi = tr_read(Vs + (r0 + 16) * KV_STRIDE + (16 * db + 4 * (l15 & 3)) * 2);
                    const h4 vlo = __builtin_bit_cast(h4, lo), vhi = __builtin_bit_cast(h4, hi);
                    const h8 va = (h8){vlo.x, vlo.y, vlo.z, vlo.w, vhi.x, vhi.y, vhi.z, vhi.w};
                    o[db] = __builtin_amdgcn_mfma_f32_16x16x32_f16(va, pf[qb][c], o[db], 0, 0, 0);
                }
            }
            const float inv = 1.0f / dens[qb];
            f16* orow = og + ((size_t)g * M + qrow) * DKV + h * 64;
#pragma unroll
            for (int db = 0; db < 4; ++db) *(h4*)(orow + 16 * db + 4 * lq) = cvt_h4(o[db] * inv);
            if (lq == 0) lse[((size_t)g * M + qrow) * NH + h] = mxs[qb] + __logf(dens[qb]);
        }
    }
    __syncthreads();
}
#undef AU_DECODE
#undef AU_FETCH
#undef AU_TO_LDS
__device__ __forceinline__ float dpp_q1(float v) { return __builtin_bit_cast(float, __builtin_amdgcn_update_dpp(0, __builtin_bit_cast(int, v), 0xB1, 0xf, 0xf, false)); }
__device__ __forceinline__ float dpp_q2(float v) { return __builtin_bit_cast(float, __builtin_amdgcn_update_dpp(0, __builtin_bit_cast(int, v), 0x4E, 0xf, 0xf, false)); }
__device__ __forceinline__ float dpp_hm(float v) { return __builtin_bit_cast(float, __builtin_amdgcn_update_dpp(0, __builtin_bit_cast(int, v), 0x141, 0xf, 0xf, false)); }
__device__ __forceinline__ float sum8(float v) { v += dpp_q1(v); v += dpp_q2(v); v += dpp_hm(v); return v; }
__device__ __forceinline__ float max8(float v) { v = fmaxf(v, dpp_q1(v)); v = fmaxf(v, dpp_q2(v)); v = fmaxf(v, dpp_hm(v)); return v; }
__device__ __forceinline__ void att_sample(Ctx& C) {
    const int tid_o = opq_tid(), lane_o = tid_o & 63, wave_o = __builtin_amdgcn_readfirstlane(tid_o >> 6);
    const f16* qh = WSP(f16, WS_QH); const f16* kh = WSP(f16, WS_KH); const f16* vh = WSP(f16, WS_VH); f16* og = WSP(f16, WS_OG); float* lse = WSP(float, WS_LSE);
    const GAS float* ck = (const GAS float*)INP(2); const GAS float* cv = (const GAS float*)INP(3);
    const int lane = lane_o, hh = lane >> 3, sub = lane & 7;
    const int gw = C.bid * NWAVES + wave_o, NGW = C.G * NWAVES;
    for (int us = gw; us < BS * 16; us += NGW) {
        const int sl = us & 15; if (sl >= 12) continue;
        const int s = sl & 3, g = sl >> 2, b = us >> 4, d = g == 0 ? 1 : (g == 1 ? 4 : 16);
        const size_t qrow = (size_t)MP + b * 4 + s;
        float q[8];
        { const h8 qv = *(const h8*)(qh + qrow * 1536 + g * 512 + hh * 64 + sub * 8);
#pragma unroll
          for (int e = 0; e < 8; ++e) q[e] = (float)qv[e]; }
        const int nn = g == 0 ? s + 1 : 1;
        float scn[4];
#pragma unroll
        for (int j = 0; j < 4; ++j) {
            scn[j] = -INFINITY;
            if (j < nn) { const size_t ro = ((size_t)MP + b * 4 + (s - j)) * DKV + lane * 8; const h8 k8 = *(const h8*)(kh + ro);
                float a = 0.f;
#pragma unroll
                for (int e = 0; e < 8; ++e) a += q[e] * (float)k8[e];
                scn[j] = sum8(a); }
        }
        const int i0 = g == 0 ? NPAST - 1 : NPAST + s - d, nvalid = g == 0 ? 128 - s : 128;
        const __amdgpu_buffer_rsrc_t kbase = __builtin_amdgcn_make_buffer_rsrc((void*)(ck + (size_t)b * NPAST * DKV), 0, NPAST * DKV * 4, 0x00020000);
        const __amdgpu_buffer_rsrc_t vbase = __builtin_amdgcn_make_buffer_rsrc((void*)(cv + (size_t)b * NPAST * DKV), 0, NPAST * DKV * 4, 0x00020000);
        const int lane32 = lane * 32;
        LAS float* SL = (LAS float*)(C.lds + 81920) + wave_o * 1024;
        float mrun = -INFINITY;
        {
            f32x4 kb0[8][2], kb1[8][2];
#define AS_LOAD(buf, base, c) do { _Pragma("unroll") for (int r_ = 0; r_ < 8; ++r_) { const int so_ = (i0 - d * ((c) * 8 + r_)) * (DKV * 4); buf[r_][0] = __builtin_bit_cast(f32x4, __builtin_amdgcn_raw_buffer_load_b128(base, lane32, so_, 0)); buf[r_][1] = __builtin_bit_cast(f32x4, __builtin_amdgcn_raw_buffer_load_b128(base, lane32 + 16, so_, 0)); } } while (0)
#define AS_SCORE(buf, c) do { float mine_ = 0.f; _Pragma("unroll") for (int r_ = 0; r_ < 8; ++r_) { const f32x4 k0_ = buf[r_][0], k1_ = buf[r_][1]; \
                float a_ = (q[0] * k0_.x + q[1] * k0_.y) + (q[2] * k0_.z + q[3] * k0_.w) + (q[4] * k1_.x + q[5] * k1_.y) + (q[6] * k1_.z + q[7] * k1_.w); \
                a_ = sum8(a_); mine_ = sub == r_ ? a_ : mine_; } \
            mine_ = ((c) * 8 + sub) < nvalid ? mine_ : -INFINITY; SL[(c) * 64 + lane] = mine_; mrun = fmaxf(mrun, mine_); } while (0)
            AS_LOAD(kb0, kbase, 0);
#pragma unroll 1
            for (int c = 0; c < 16; c += 2) {
                AS_LOAD(kb1, kbase, c + 1); __builtin_amdgcn_sched_barrier(0);
                AS_SCORE(kb0, c); __builtin_amdgcn_sched_barrier(0);
                if (c + 2 < 16) AS_LOAD(kb0, kbase, c + 2);
                __builtin_amdgcn_sched_barrier(0);
                AS_SCORE(kb1, c + 1); __builtin_amdgcn_sched_barrier(0);
            }
        }
        float mx = fmaxf(fmaxf(fmaxf(scn[0], scn[1]), fmaxf(scn[2], scn[3])), max8(mrun));
        float den = 0.f, o[8];
#pragma unroll
        for (int e = 0; e < 8; ++e) o[e] = 0.f;
#pragma unroll
        for (int j = 0; j < 4; ++j) if (j < nn) { const float p = __expf(scn[j] - mx); den += p; const h8 v8 = *(const h8*)(vh + ((size_t)MP + b * 4 + (s - j)) * DKV + lane * 8);
#pragma unroll
            for (int e = 0; e < 8; ++e) o[e] += p * (float)v8[e]; }
        {
            f32x4 vb0[8][2], vb1[8][2];
            const LAS float* SLr = SL + (lane & ~7);
#define AS_PV(buf, c) do { _Pragma("unroll") for (int r_ = 0; r_ < 8; ++r_) { const float w_ = __expf(SLr[(c) * 64 + r_] - mx); den += w_; const f32x4 v0_ = buf[r_][0], v1_ = buf[r_][1]; \
                o[0] += w_ * v0_.x; o[1] += w_ * v0_.y; o[2] += w_ * v0_.z; o[3] += w_ * v0_.w; o[4] += w_ * v1_.x; o[5] += w_ * v1_.y; o[6] += w_ * v1_.z; o[7] += w_ * v1_.w; } } while (0)
            AS_LOAD(vb0, vbase, 0);
#pragma unroll 1
            for (int c = 0; c < 16; c += 2) {
                AS_LOAD(vb1, vbase, c + 1); __builtin_amdgcn_sched_barrier(0);
                AS_PV(vb0, c); __builtin_amdgcn_sched_barrier(0);
                if (c + 2 < 16) AS_LOAD(vb0, vbase, c + 2);
                __builtin_amdgcn_sched_barrier(0);
                AS_PV(vb1, c + 1); __builtin_amdgcn_sched_barrier(0);
            }
#undef AS_LOAD
#undef AS_SCORE
#undef AS_PV
        }
        const float inv = 1.0f / den;
        h8 r8;
#pragma unroll
        for (int e = 0; e < 8; ++e) r8[e] = (f16)(o[e] * inv);
        *(h8*)(og + ((size_t)g * M + qrow) * DKV + hh * 64 + sub * 8) = r8;
        if (sub == 0) lse[((size_t)g * M + qrow) * NH + hh] = mx + __logf(den);
    }
}

constexpr int NPHASE = 43;
__host__ __device__ constexpr bool phase_exists(int k) {
    if (k == 0) return true;
    const int L = (k - 1) / 11, p = (k - 1) % 11;
    if (p == 7 || p == 10) return false;
    if (L < 2) { if (p == 1 || p == 3) return false; if (p <= 8) return true; return L == 1; }
    if (p == 3 || p == 4 || p == 5) return false;
    if (p <= 8) return true;
    return L == 2;
}
#ifndef PHASE_MASK
#define PHASE_MASK 0xFFFFFFFFu
#endif
#define PHM(b) ((PHASE_MASK >> (b)) & 1u)
#define REPS(b) (((REP_MASK >> (b)) & 1u) ? REP_N : 0)
#define IN(k) (lo <= (k) && (k) < hi && fresh(C))
#define SEAM(k) do { if (multi && (k) + 1 < hi) xcd_barrier(bar); } while (0)
template <int L>
__device__ __forceinline__ void layer_body(Ctx& C, const int lo, const int hi, const bool multi, const XcdBarrier& bar) {
        const int pb = 1 + 11 * L;
        if (L < 2) {
            if (PHM(1) && IN(pb + 0)) {
                for (int rep = 0; rep <= REPS(1); ++rep) {
                    { EpiGateGelu eg{WSP(float, WS_SS), nullptr, WSP(f16, WS_GG)}; Pg8Epi<EpiGateGelu> pe{eg};
                      pg8::Gemm g{WSP(f16, WS_XH), WSP(f16, WS_WIN) + (size_t)L * 2048 * D, D, D, MP, 1024, D, 0, C.wave}; pg8::StaticOrder S; S.init(MP, 1024, C.G, C.bid);
                      pg8::gemm_phase<Pg8Epi<EpiGateGelu>>(C.lds, g, S, pe); }
                                        MiniInConv me{WSP(float, WS_SS), INP(9) + (size_t)L * 4 * D, INP(10) + (size_t)L * D, INP(5) + (size_t)L * BS * 3 * D, WSP(f16, WS_GG), WSP(f16, WS_XC), OUTP + O_SCONV + (size_t)L * BS * 3 * D}; MiniPre<D> pre; pre.valid = false; MiniPost<MiniInConv, D> post{&C, WSP(f16, WS_XH), D, WSP(f16, WS_WIN) + (size_t)L * 2048 * D, D, &me, &pre};
                    { EpiInConv e{WSP(float, WS_SS), INP(9) + (size_t)L * 4 * D, INP(10) + (size_t)L * D, WSP(f16, WS_XC), WSP(float, WS_SIDEAF), WSP(float, WS_SIDEAL), OUTP + O_PCONV + (size_t)L * BP * 3 * D, (LAS float*)(C.lds + HALO_OFF)};
                      pg8::Gemm g{WSP(f16, WS_XH), WSP(f16, WS_WIN) + (size_t)L * 2048 * D + (size_t)1024 * D, D, D, MP, 1024, D, 0, C.wave}; pg8::StaticOrder S; S.init(MP, 1024, C.G, C.bid);
                      pg8::gemm_phase<EpiInConv>(C.lds, g, S, e); }
                    VM_WAIT(); __syncthreads();

                    warm_panel(C, WSP(f16, WS_WG) + (size_t)L * 2048 * 256, (size_t)2048 * 256 * 2);
                    mini_gemm64<MiniInConv, D>(C, WSP(f16, WS_XH), D, WSP(f16, WS_WIN) + (size_t)L * 2048 * D, D, me);
                }
                SEAM(pb + 0); }
            if (PHM(3) && IN(pb + 2)) {
                for (int rep = 0; rep <= REPS(3); ++rep) {
                    EpiScan e{INP(12) + (size_t)L * D, INP(14) + (size_t)L * D, WSP(float, WS_SPL) + (size_t)L * D, WSP(f16, WS_XC), WSP(f16, WS_LA), WSP(f16, WS_IX), WSP(float, WS_CA), WSP(float, WS_CH), (LAS float*)(C.lds + HALO_OFF)};
                    pg8::Gemm g{WSP(f16, WS_XC), WSP(f16, WS_WG) + (size_t)L * 2048 * 256, D, 256, MP, 2048, 256, 512, C.wave}; pg8::StaticOrder S; S.init(MP, 2048, C.G, C.bid);
                    { pg8::Unit uf; for (int i = 0; S.next(i, uf); ++i) g2_fixup(C, L, uf.pm, uf.pn >> 1); VM_WAIT(); __syncthreads(); }
                    MiniScan me{nullptr, INP(12) + (size_t)L * D, INP(14) + (size_t)L * D, WSP(float, WS_SPL) + (size_t)L * D, WSP(f16, WS_XC), WSP(f16, WS_GG), INP(4) + (size_t)L * BS * D, WSP(f16, WS_Y), OUTP + O_SH + (size_t)L * BS * D};
                    MiniPre<256> pre; pre.valid = false; MiniPost<MiniScan, 256> post{&C, WSP(f16, WS_XC), D, WSP(f16, WS_WG) + (size_t)L * 2048 * 256, 256, &me, &pre};
                    pg8::gemm_phase<EpiScan>(C.lds, g, S, e);
                    VM_WAIT(); __syncthreads();
                    mini_gemm64<MiniScan, 256>(C, WSP(f16, WS_XC), D, WSP(f16, WS_WG) + (size_t)L * 2048 * 256, 256, me);
                }
                SEAM(pb + 2); }
            if (PHM(5) && IN(pb + 4)) { warm_panel(C, WSP(f16, WS_WOUT) + (size_t)L * D * D, (size_t)D * D * 2); for (int rep = 0; rep <= REPS(5); ++rep) y_apply(C, L); SEAM(pb + 4); }
            if (PHM(6) && IN(pb + 5)) {
                EpiRes e{nullptr, WSP(float, WS_SS), nullptr, nullptr, nullptr, WSP(f16, WS_XH)};
                EpiRes ed = e; ed.ss_out = WSP(float, WS_DUMS); ed.xout = WSP(float, WS_DUMX);
                for (int rep = REPS(6); rep >= 0; --rep) gemm_both<EpiRes, D>(C, WSP(f16, WS_Y), D, WSP(f16, WS_WOUT) + (size_t)L * D * D, D, D, 0, rep == 0 ? e : ed, ed, WSP(f16, WS_WUP) + (size_t)L * 6144 * D, (size_t)6144 * D * 2);
                SEAM(pb + 5); }
        } else {
            if (IN(pb + 0)) {
                if ((C.G & 15) == 0) {
                    constexpr int OW = 3;
                    const int per = C.G >> 3, x = C.bid & 7, j = C.bid >> 3, nwk = 4 * (1 + OW) * per, base = (x >> 1) * ((1 + OW) * per) + ((x & 1) ? per : 0);
                    if (x & 1) { att_sample(C); for (int k = 0; k < OW; ++k) att_prompt(C, base + OW * j + k, nwk); }
                    else { att_prompt(C, base + j, nwk); att_sample(C); }
                } else {
                    const int vb0 = (C.G & 7) == 0 ? (C.bid & 7) * (C.G >> 3) + (C.bid >> 3) : C.bid;
                    if (C.bid & 1) att_sample(C);
                    att_prompt(C, vb0, C.G);
                    if (!(C.bid & 1)) att_sample(C);
                }
                SEAM(pb + 0); }
            if (PHM(8) && IN(pb + 1)) { warm_panel(C, WSP(f16, WS_WO) + (size_t)(L - 2) * D * 512, (size_t)D * 512 * 2); for (int rep = 0; rep <= REPS(8); ++rep) e5_merge(C); SEAM(pb + 1); }
            if (PHM(9) && IN(pb + 2)) {
                EpiRes e{nullptr, WSP(float, WS_SS), nullptr, nullptr, nullptr, WSP(f16, WS_XH)};
                EpiRes ed = e; ed.ss_out = WSP(float, WS_DUMS); ed.xout = WSP(float, WS_DUMX);
                for (int rep = REPS(9); rep >= 0; --rep) gemm_both<EpiRes, 512>(C, WSP(f16, WS_ATT), 512, WSP(f16, WS_WO) + (size_t)(L - 2) * D * 512, 512, D, 0, rep == 0 ? e : ed, ed, WSP(f16, WS_WUP) + (size_t)L * 6144 * D, (size_t)6144 * D * 2);
                SEAM(pb + 2); }
        }
        if (PHM(10) && IN(pb + 6)) {
            for (int rep = 0; rep <= REPS(10); ++rep) {
                EpiGeglu e{WSP(float, WS_SS), INP(26) + (size_t)L * 3 * DFF, INP(27) + (size_t)L * DFF, WSP(f16, WS_MID), WSP(float, WS_SIDEF), WSP(float, WS_SIDEL), OUTP + O_PFFN + (size_t)L * BP * 2 * DFF, (LAS float*)(C.lds + HALO_OFF)};
                pg8::Gemm g{WSP(f16, WS_XH), WSP(f16, WS_WUP) + (size_t)L * 6144 * D, D, D, MP, 6144, D, 0, C.wave}; pg8::StaticOrder S; S.init(MP, 6144, C.G, C.bid); S.dup = (REP_MASK >> 22) & 1;
                MiniGeglu me{WSP(float, WS_SS), INP(26) + (size_t)L * 3 * DFF, INP(27) + (size_t)L * DFF, INP(6) + (size_t)L * BS * 2 * DFF, WSP(f16, WS_MID), OUTP + O_SFFN + (size_t)L * BS * 2 * DFF};
                MiniPre<D> pre; pre.valid = false; MiniPost<MiniGeglu, D> post{&C, WSP(f16, WS_XH), D, WSP(f16, WS_WUP) + (size_t)L * 6144 * D, D, &me, &pre};
                pg8::gemm_phase<EpiGeglu>(C.lds, g, S, e);
                VM_WAIT(); __syncthreads();

                warm_panel(C, WSP(f16, WS_WDN) + (size_t)L * D * DFF, (size_t)D * DFF * 2);
                mini_gemm64<MiniGeglu, D>(C, WSP(f16, WS_XH), D, WSP(f16, WS_WUP) + (size_t)L * 6144 * D, D, me);
            }
            SEAM(pb + 6); }
        if (PHM(12) && IN(pb + 8)) {
            EpiRes e{nullptr, WSP(float, WS_SS), nullptr, nullptr, L == 3 ? OUTP : nullptr, WSP(f16, WS_XH)};
            EpiRes ed = e; ed.ss_out = WSP(float, WS_DUMS); ed.xout = WSP(float, WS_DUMX);
            { pg8::StaticOrder S0; S0.init(MP, D, C.G, C.bid); pg8::Unit u0; if (S0.next(0, u0)) g5_fixup(C, L, u0.pm); }
            for (int rep = REPS(12); rep >= 0; --rep) gemm_both<EpiRes, DFF>(C, WSP(f16, WS_MID), DFF, WSP(f16, WS_WDN) + (size_t)L * D * DFF, DFF, D, 0, rep == 0 ? e : ed, ed,
                    L == 0 ? (const void*)(WSP(f16, WS_WIN) + (size_t)2048 * D) : (L == 1 ? (const void*)WSP(f16, WS_WKVQ) : (L == 2 ? (const void*)WSP(f16, WS_WQ1) : nullptr)), L == 0 ? (size_t)2048 * D * 2 : (L == 1 ? (size_t)2560 * D * 2 : (L == 2 ? (size_t)1536 * D * 2 : 0)));
            SEAM(pb + 8); }
        if (L == 1 || L == 2) {
            if (PHM(13) && IN(pb + 9)) {
                for (int rep = 0; rep <= REPS(13); ++rep) {
                    const int mode = L == 1 ? 0 : 1, N = L == 1 ? 2560 : 1536; const f16* Wt = L == 1 ? WSP(f16, WS_WKVQ) : WSP(f16, WS_WQ1);
                    EpiKVQ e{WSP(float, WS_SS), WSP(float, WS_ROPE), INP(19), INP(22) + (size_t)mode * HD, WSP(f16, WS_KH), WSP(f16, WS_VH), WSP(f16, WS_QH), OUTP, mode};
                    pg8::Gemm g{WSP(f16, WS_XH), Wt, D, D, M, N, D, 0, C.wave}; pg8::StaticOrder S; S.init(M, N, C.G, C.bid);
                    pg8::gemm_phase<EpiKVQ>(C.lds, g, S, e);
                    if (rep == 0) {
                        const int nwg = (M / 256) * (N / 256), nfull = nwg / C.G, busy = nwg - nfull * C.G;
                        if (C.bid >= busy) { VM_WAIT(); __syncthreads(); convert_weights(C, L == 1 ? 1 : 2, L == 1 ? CV_B : CV_C, C.bid - busy, C.G - busy); }
                    }
                }
                SEAM(pb + 9); }
        }
}
__global__ void __launch_bounds__(NWAVES * 64, 2) fwd_kernel(Args args) {
    extern __shared__ __attribute__((aligned(16))) unsigned char lds_raw[];
    Ctx C;
    C.lds = (LAS unsigned char*)lds_raw;
    C.G = gridDim.x; C.bid = blockIdx.x; C.wave = __builtin_amdgcn_readfirstlane((int)threadIdx.x >> 6);
    C.in = args.in; C.out = (GAS float*)args.out; C.ws = (GAS unsigned char*)args.ws;
    volatile LAS unsigned* MISC = (volatile LAS unsigned*)(C.lds + MISC_OFF);
    for (int u = threadIdx.x; u < (LDS_BYTES - LDSCTL_OFF) / 4; u += NWAVES * 64) ((LAS unsigned*)(C.lds + LDSCTL_OFF))[u] = 0u;
    __syncthreads();
    const int lo = args.ph_lo, hi = args.ph_hi;
    const bool multi = (hi - lo) > 1;
    XcdBarrier bar; bar.bar = (unsigned*)(GAS unsigned*)(C.ws + WS_CTL) + CW_BAR; bar.x = 0; bar.st = nullptr; bar.w0 = C.wave == 0;
    if (multi) bar = xcd_barrier_post((unsigned*)(GAS unsigned*)(C.ws + WS_CTL) + CW_BAR, MISC + 8, C.wave == 0);

    if (PHM(0) && IN(0)) { for (int rep = 0; rep <= REPS(0); ++rep) p0_prologue(C); SEAM(0); }

    layer_body<0>(C, lo, hi, multi, bar); layer_body<1>(C, lo, hi, multi, bar); layer_body<2>(C, lo, hi, multi, bar); layer_body<3>(C, lo, hi, multi, bar);
#undef IN
#undef SEAM
}

#ifndef N_LAUNCH_MODE
#define N_LAUNCH_MODE 1
#endif
extern "C" void kernel_launch(void* const* d_in, const int* in_sizes, int n_in, void* d_out, int out_size, void* d_ws, size_t ws_size, hipStream_t stream) {
    static int grid = 0;
    if (grid == 0) {
        if (n_in != 29 || ws_size < WS_END) { fprintf(stderr, "kernel_launch: unexpected n_in %d or ws %zu (< %zu)\n", n_in, ws_size, (size_t)WS_END); grid = -1; return; }
        int dev = 0, cus = 0, per_cu = 0;
        if (hipGetDevice(&dev) != hipSuccess || hipDeviceGetAttribute(&cus, hipDeviceAttributeMultiprocessorCount, dev) != hipSuccess) { grid = -1; return; }
        if (hipFuncSetAttribute((const void*)fwd_kernel, hipFuncAttributeMaxDynamicSharedMemorySize, LDS_BYTES) != hipSuccess) { fprintf(stderr, "kernel_launch: hipFuncSetAttribute failed\n"); grid = -1; return; }
        if (hipOccupancyMaxActiveBlocksPerMultiprocessor(&per_cu, (const void*)fwd_kernel, NWAVES * 64, LDS_BYTES) != hipSuccess || per_cu < 1) fprintf(stderr, "kernel_launch: occupancy query says %d\n", per_cu);
        (void)hipGetLastError();
        grid = cus;
    }
    if (grid < 0) return;
    (void)hipMemsetAsync((char*)d_ws + WS_CTL, 0, CTL_ZERO_BYTES, stream);
    Args a{};
    for (int i = 0; i < 29; ++i) a.in[i] = (const float*)d_in[i];
    a.out = (float*)d_out; a.ws = (unsigned char*)d_ws;
#if N_LAUNCH_MODE == 1
    a.ph_lo = 0; a.ph_hi = NPHASE;
    hipLaunchKernelGGL(fwd_kernel, dim3(grid), dim3(NWAVES * 64), LDS_BYTES, stream, a);
#else
    for (int k = 0; k < NPHASE; ++k) {
        if (!phase_exists(k)) continue;
        a.ph_lo = k; a.ph_hi = k + 1;
        hipLaunchKernelGGL(fwd_kernel, dim3(grid), dim3(NWAVES * 64), LDS_BYTES, stream, a);
    }
#endif
}
```

```cpp
#include <hip/hip_runtime.h>
#include <cstdio>
#include <cstdint>

#ifndef REP_MASK
#define REP_MASK 0x0u
#endif
#ifndef REP_N
#define REP_N 1
#endif
#define LAS __attribute__((address_space(3)))
#define GAS __attribute__((address_space(1)))
typedef _Float16 f16;
typedef _Float16 h8 __attribute__((ext_vector_type(8)));
typedef _Float16 h4 __attribute__((ext_vector_type(4)));
typedef _Float16 h2 __attribute__((ext_vector_type(2)));
typedef float f32x4 __attribute__((ext_vector_type(4)));
typedef float f32x2 __attribute__((ext_vector_type(2)));
typedef unsigned u32x4 __attribute__((ext_vector_type(4)));
typedef unsigned u32x2 __attribute__((ext_vector_type(2)));
typedef short s16x4 __attribute__((ext_vector_type(4)));

constexpr int D = 1024, SEQ = 4096, BP = 4, MP = BP * SEQ, BS = 128, TS = 4, MS = BS * TS, M = MP + MS;
constexpr int DFF = 3072, NH = 8, HD = 64, NG = 3, DKV = NH * HD, NPAST = 2048;
constexpr float EPS = 1e-6f;

constexpr size_t O_YP = 0, O_YS = 16777216, O_PH = 17301504, O_PCONV = 17309696, O_PFFN = 17334272, O_PCK = 17432576, O_PCV = 21626880,
                 O_SH = 25821184, O_SCONV = 26083328, O_SFFN = 26869760, O_SCK = 30015488, O_SCV = 30277632;

constexpr size_t MiB = 1u << 20;
constexpr size_t WS_CTL = 0, CTL_ZERO_BYTES = 32768;
constexpr size_t WS_WIN = 2 * MiB;
constexpr size_t WS_WG = WS_WIN + 8 * MiB;
constexpr size_t WS_WOUT = WS_WG + 2 * MiB;
constexpr size_t WS_WKVQ = WS_WOUT + 4 * MiB;
constexpr size_t WS_WQ1 = WS_WKVQ + 5 * MiB;
constexpr size_t WS_WO = WS_WQ1 + 3 * MiB;
constexpr size_t WS_WUP = WS_WO + 2 * MiB;
constexpr size_t WS_WDN = WS_WUP + 48 * MiB;
constexpr size_t WS_XRES = WS_WDN + 24 * MiB;
constexpr size_t WS_XH = WS_XRES + 66 * MiB;
constexpr size_t WS_SS = WS_XH + 33 * MiB;
constexpr size_t WS_GG = WS_SS + 2 * MiB;
constexpr size_t WS_XB = WS_GG + 33 * MiB;
constexpr size_t WS_XC = WS_XB + 33 * MiB;
constexpr size_t WS_Y = WS_XC + 33 * MiB;
constexpr size_t WS_LA = WS_Y + 33 * MiB;
constexpr size_t WS_IX = WS_LA + 66 * MiB;
constexpr size_t WS_G = WS_IX + 66 * MiB;
constexpr size_t WS_V = WS_G + 99 * MiB;
constexpr size_t WS_MID = WS_V + 99 * MiB;
constexpr size_t WS_RAW = WS_MID + 99 * MiB;
constexpr size_t WS_KH = WS_RAW + 165 * MiB;
constexpr size_t WS_VH = WS_KH + 17 * MiB;
constexpr size_t WS_QH = WS_VH + 17 * MiB;
constexpr size_t WS_OG = WS_QH + 50 * MiB;
constexpr size_t WS_LSE = WS_OG + 50 * MiB;
constexpr size_t WS_ATT = WS_LSE + 2 * MiB;
constexpr size_t WS_CA = WS_ATT + 17 * MiB;
constexpr size_t WS_CH = WS_CA + 1 * MiB;
constexpr size_t WS_SPL = WS_CH + 1 * MiB;
constexpr size_t WS_SIDEF = WS_SPL + 1 * MiB;
constexpr size_t WS_SIDEL = WS_SIDEF + 3 * MiB;
constexpr size_t WS_ROPE = WS_SIDEL + 2 * MiB;
constexpr size_t WS_SIDEAF = WS_ROPE + 1 * MiB;
constexpr size_t WS_SIDEAL = WS_SIDEAF + 1 * MiB;
constexpr size_t WS_DUMX = WS_SIDEAL + 1 * MiB;
constexpr size_t WS_DUMH = WS_DUMX + 66 * MiB;
constexpr size_t WS_DUMS = WS_DUMH + 33 * MiB;
constexpr size_t WS_END = WS_DUMS + 2 * MiB;

constexpr int CW_BAR = 4096;
constexpr int NWAVES = 8;
constexpr int RING_BYTES = 131072, LDSCTL_OFF = RING_BYTES, MISC_OFF = LDSCTL_OFF + 320, HALO_OFF = RING_BYTES + 1024, LDS_BYTES = 147456;

namespace pg8 {
constexpr int BM = 256, BK = 64, HALF = 128, HTB = HALF * BK * 2, STAGE_BYTES = 8 * HTB, NXCD = 8, WGM = 8;
__host__ __device__ __forceinline__ int lds_byte(int r, int c) { const int st = (r >> 4) * 2 + (c >> 5), rr = r & 15, cc = c & 31, ob = rr * 64 + cc * 2; return st * 1024 + (ob ^ (((ob >> 9) & 1) << 5)); }
__host__ __device__ __forceinline__ void stage_rc(int b, int& R, int& C) { const int st = b / 1024, sb = b % 1024, swz = sb ^ (((sb >> 9) & 1) << 5); R = (st >> 1) * 16 + swz / 64; C = (st & 1) * 32 + (swz % 64) / 2; }
__host__ __device__ __forceinline__ int perm32(int rho) { const int n = rho >> 4, i = rho & 15; return 8 * (i >> 2) + 4 * n + (i & 3); }
struct Unit { int pm, pn; };
struct Gemm { const f16* A; const f16* Bt; int lda, ldb, M, N, K, a_pn_bytes, wave; };
struct StaticOrder {
    int nM, nN, nwg, G, c, dup;
    __device__ __forceinline__ void init(int M_, int N_, int G_, int c_) { nM = M_ / BM; nN = N_ / BM; nwg = nM * nN; G = G_; c = c_; dup = 0; }
    __device__ __forceinline__ bool next(int i, Unit& u) const {
        const long L = (long)(i >> dup) * G + c; if (L >= nwg) return false;
        int wgid = (int)L; { const int q = nwg / NXCD, r = nwg % NXCD, xcd = wgid % NXCD, off = wgid / NXCD; wgid = (xcd < r ? xcd * (q + 1) : r * (q + 1) + (xcd - r) * q) + off; }
        const int nig = WGM * nN, gid = wgid / nig, fm = gid * WGM, gsz = (nM - fm) < WGM ? (nM - fm) : WGM;
        u.pm = fm + ((wgid % nig) % gsz); u.pn = (wgid % nig) / gsz; return true;
    }
};
struct NoPost { __device__ __forceinline__ void operator()() const {} };
template <class Epi, class Post = NoPost>
__device__ __forceinline__ void gemm_phase(LAS unsigned char* lds, const Gemm g, const StaticOrder& S, const Epi& E, const Post& post = Post()) {
    int tid_; asm volatile("v_mbcnt_lo_u32_b32 %0, -1, 0\n\tv_mbcnt_hi_u32_b32 %0, -1, %0" : "=v"(tid_)); tid_ += g.wave * 64; asm volatile("" : "+v"(tid_));
    const int tid = tid_, wid = __builtin_amdgcn_readfirstlane(tid >> 6), lane = tid & 63, wr = wid >> 2, wc = wid & 3, fr = lane & 15, fq = lane >> 4;
    const int K = g.K, nt = K / BK;
    unsigned voffA[2], voffB[2];
#pragma unroll
    for (int i = 0; i < 2; ++i) { int R, C; stage_rc(tid * 16 + i * 8192, R, C); const int Rb = (R & ~31) + perm32(R & 31);
        voffA[i] = (unsigned)(R * g.lda + C) * 2u; voffB[i] = (unsigned)(Rb * g.ldb + C) * 2u; }
    const size_t kstep = (size_t)(BK * 2);
    const size_t hstepA = (size_t)HALF * g.lda * 2, hstepB = (size_t)HALF * g.ldb * 2;
    const size_t tstepA = 2 * hstepA, tstepB = 2 * hstepB;
    const unsigned ldsw = (unsigned)wid * 1024u;
    const int aoff = lds_byte(wr * 64 + fr, fq * 8), boff = lds_byte(wc * 32 + fr, fq * 8);
#define PG8_SA(b, h) (((b) * 2 + (h)) * HTB)
#define PG8_SB(b, h) ((4 + (b) * 2 + (h)) * HTB)
#define PG8_STAGE(bufoff, gbase, voff) do { _Pragma("unroll") for (int _i = 0; _i < 2; ++_i) \
        __builtin_amdgcn_global_load_lds((const unsigned*)((const char*)(gbase) + (voff)[_i]), (LAS unsigned*)(lds + (bufoff) + ldsw + _i * 8192), 16, 0, 0); } while (0)
#define PG8_LDA(dst, b, h) do { _Pragma("unroll") for (int m = 0; m < 4; ++m) _Pragma("unroll") for (int k = 0; k < 2; ++k) dst[m][k] = *(const LAS h8*)(lds + PG8_SA(b, h) + aoff + m * 2048 + k * 1024); } while (0)
#define PG8_LDB(dst, b, h) do { _Pragma("unroll") for (int n = 0; n < 2; ++n) _Pragma("unroll") for (int k = 0; k < 2; ++k) dst[n][k] = *(const LAS h8*)(lds + PG8_SB(b, h) + boff + n * 2048 + k * 1024); } while (0)
#define PG8_MMA(ai, bj, At, Bt) do { __builtin_amdgcn_s_setprio(1); _Pragma("unroll") for (int m = 0; m < 4; ++m) _Pragma("unroll") for (int n = 0; n < 2; ++n) _Pragma("unroll") for (int k = 0; k < 2; ++k) \
        acc[ai][bj][m][n] = __builtin_amdgcn_mfma_f32_16x16x32_f16(Bt[n][k], At[m][k], acc[ai][bj][m][n], 0, 0, 0); __builtin_amdgcn_s_setprio(0); } while (0)
#define PG8_WAIT_V(n) asm volatile("s_waitcnt vmcnt(" #n ")" ::: "memory")
#define PG8_WAIT_L(n) asm volatile("s_waitcnt lgkmcnt(" #n ")" ::: "memory")
#define PG8_BAR __builtin_amdgcn_s_barrier()
#define PG8_SCHED __builtin_amdgcn_sched_barrier(0)
    Unit cur, nxt; int ui = 0;
    if (!S.next(0, cur)) return;
    f32x4 acc[2][2][4][2];
#pragma unroll
    for (int a = 0; a < 2; ++a)
#pragma unroll
        for (int b = 0; b < 2; ++b)
#pragma unroll
            for (int m = 0; m < 4; ++m)
#pragma unroll
                for (int n = 0; n < 2; ++n) acc[a][b][m][n] = (f32x4){0.f, 0.f, 0.f, 0.f};
    h8 At[4][2], B0[2][2], B1[2][2];
    const char* cA = (const char*)g.A + (size_t)cur.pm * tstepA + (size_t)(cur.pn >> 1) * g.a_pn_bytes; const char* cB = (const char*)g.Bt + (size_t)cur.pn * tstepB;
    PG8_STAGE(PG8_SB(0, 0), cB, voffB); PG8_STAGE(PG8_SB(0, 1), cB + hstepB, voffB); PG8_STAGE(PG8_SA(0, 0), cA, voffA); PG8_STAGE(PG8_SA(0, 1), cA + hstepA, voffA);
    if (wr == 1) PG8_BAR;
    PG8_WAIT_V(2); PG8_BAR;
    PG8_STAGE(PG8_SB(1, 0), cB + kstep, voffB); PG8_STAGE(PG8_SA(1, 0), cA + kstep, voffA); PG8_STAGE(PG8_SB(1, 1), cB + hstepB + kstep, voffB);
    PG8_WAIT_V(6); PG8_BAR;
    for (;;) {
        const bool has_next = S.next(ui + 1, nxt);
        const char* nA = has_next ? (const char*)g.A + (size_t)nxt.pm * tstepA + (size_t)(nxt.pn >> 1) * g.a_pn_bytes : cA; const char* nB = has_next ? (const char*)g.Bt + (size_t)nxt.pn * tstepB : cB;
#pragma unroll 1
        for (int t = 0; t < nt; t += 2) {
            const bool last = (t == nt - 2);
            const char* a1 = cA + (size_t)(t + 1) * kstep;
            const char* a2 = last ? nA : cA + (size_t)(t + 2) * kstep; const char* b2 = last ? nB : cB + (size_t)(t + 2) * kstep;
            const char* a3 = a2 + kstep; const char* b3 = b2 + kstep;
            PG8_LDB(B0, 0, 0); PG8_LDB(B1, 0, 1); PG8_SCHED; PG8_LDA(At, 0, 0); PG8_STAGE(PG8_SA(1, 1), a1 + hstepA, voffA);
            PG8_WAIT_V(8); PG8_WAIT_L(0); PG8_BAR; PG8_MMA(0, 0, At, B0); PG8_MMA(0, 1, At, B1); PG8_BAR; PG8_SCHED;
            PG8_LDA(At, 0, 1); PG8_STAGE(PG8_SB(0, 0), b2, voffB); PG8_STAGE(PG8_SB(0, 1), b2 + hstepB, voffB); PG8_STAGE(PG8_SA(0, 0), a2, voffA);
            PG8_WAIT_V(8); PG8_WAIT_L(0); PG8_BAR; PG8_MMA(1, 0, At, B0); PG8_MMA(1, 1, At, B1); PG8_BAR; PG8_SCHED;
            PG8_LDB(B0, 1, 0); PG8_LDB(B1, 1, 1); PG8_SCHED; PG8_LDA(At, 1, 0); PG8_STAGE(PG8_SA(0, 1), a2 + hstepA, voffA);
            PG8_WAIT_V(8); PG8_WAIT_L(0); PG8_BAR; PG8_MMA(0, 0, At, B0); PG8_MMA(0, 1, At, B1); PG8_BAR; PG8_SCHED;
            PG8_LDA(At, 1, 1); PG8_STAGE(PG8_SB(1, 0), b3, voffB); PG8_STAGE(PG8_SB(1, 1), b3 + hstepB, voffB); PG8_STAGE(PG8_SA(1, 0), a3, voffA);
            PG8_WAIT_V(8); PG8_WAIT_L(0); PG8_BAR; PG8_MMA(1, 0, At, B0); PG8_MMA(1, 1, At, B1); PG8_BAR; PG8_SCHED;
        }
        if (wr == 0) PG8_BAR;
        if (!(S.dup && !(ui & 1))) E(acc, cur, wr, wc, fr, fq);
        if (!has_next) break;
#pragma unroll
        for (int a = 0; a < 2; ++a)
#pragma unroll
            for (int b = 0; b < 2; ++b)
#pragma unroll
                for (int m = 0; m < 4; ++m)
#pragma unroll
                    for (int n = 0; n < 2; ++n) acc[a][b][m][n] = (f32x4){0.f, 0.f, 0.f, 0.f};
        cur = nxt; cA = nA; cB = nB; ++ui;
        if (wr == 1) PG8_BAR;
    }
    post();
    PG8_WAIT_V(0);
    PG8_BAR;
#undef PG8_SA
#undef PG8_SB
#undef PG8_STAGE
#undef PG8_LDA
#undef PG8_LDB
#undef PG8_MMA
#undef PG8_WAIT_V
#undef PG8_WAIT_L
#undef PG8_BAR
#undef PG8_SCHED
}
}

#define LDS_WAIT() asm volatile("s_waitcnt lgkmcnt(0)" ::: "memory")
#define VM_WAIT() asm volatile("s_waitcnt vmcnt(0)" ::: "memory")
__device__ __forceinline__ h4 cvt_h4(f32x4 v) { const h2 a = __builtin_convertvector((f32x2){v.x, v.y}, h2), b = __builtin_convertvector((f32x2){v.z, v.w}, h2); return (h4){a.x, a.y, b.x, b.y}; }
__device__ __forceinline__ f32x4 cvt_f4(h4 v) { return (f32x4){(float)v.x, (float)v.y, (float)v.z, (float)v.w}; }
__device__ __forceinline__ float rcpf(float x) { return __builtin_amdgcn_rcpf(x); }
__device__ __forceinline__ float sigmoidf_(float z) { return rcpf(1.0f + __expf(-z)); }
__device__ __forceinline__ float gelu_tanh(float x) { const float t = __builtin_fmaf(x * x, -0.10294324f, -2.3022082f); return x * rcpf(1.0f + __builtin_amdgcn_exp2f(x * t)); }
__device__ __forceinline__ int hw_lane() { int l; asm volatile("v_mbcnt_lo_u32_b32 %0, -1, 0\n\tv_mbcnt_hi_u32_b32 %0, -1, %0" : "=v"(l)); return l; }
__device__ __forceinline__ int opq_tid_(int wave) { int t = wave * 64 + hw_lane(); asm volatile("" : "+v"(t)); return t; }
#define opq_tid() opq_tid_(C.wave)
__device__ __forceinline__ float wave_sum(float v) {
#pragma unroll
    for (int o = 1; o < 64; o <<= 1) v += __shfl_xor(v, o);
    return v;
}

#define XB_TMO      128
#define XB_XCNT(j)  (256  + 64 * (j))
#define XB_XSUB(j)  (1280 + 64 * (j))
#define XB_XGEN(j)  (2304 + 64 * (j))
#define XB_TOP      3328
#define XB_TOPGEN   3392
#define XCD_BAR_WORDS 3456
#define XB_SPIN_CAP (1u << 18)
__device__ __forceinline__ unsigned xb_ld(unsigned* p)              { return __hip_atomic_load(p, __ATOMIC_RELAXED, __HIP_MEMORY_SCOPE_AGENT); }
__device__ __forceinline__ unsigned xb_add(unsigned* p, unsigned v) { return __hip_atomic_fetch_add(p, v, __ATOMIC_RELAXED, __HIP_MEMORY_SCOPE_AGENT); }
__device__ __forceinline__ unsigned xb_xcc_id() { return (unsigned)__builtin_amdgcn_s_getreg((3 << 11) | 20) & 0xFu; }
#define XB_SPIN(cond, bar) do { unsigned _sp = 0; while (cond) { __builtin_amdgcn_s_sleep(1); \
    if ((++_sp & 255u) == 0u) { if (xb_ld(&(bar)[XB_TMO])) break; if (_sp > XB_SPIN_CAP) { atomicAdd(&(bar)[XB_TMO], 1u); break; } } } } while (0)
struct XcdBarrier { unsigned* bar; unsigned x; volatile LAS unsigned* st; bool w0; };
__device__ __forceinline__ XcdBarrier xcd_barrier_post(unsigned* bar, volatile LAS unsigned* st, bool w0) {
    XcdBarrier b; b.bar = bar; b.x = xb_xcc_id(); b.st = st; b.w0 = w0;
    if (w0 && hw_lane() == 0) (void)xb_add(&bar[XB_XCNT(b.x)], 1u);
    return b;
}
__device__ __forceinline__ void xcd_barrier_complete(unsigned* bar, unsigned x, unsigned& nloc, unsigned& nx) {
    const unsigned G = gridDim.x * gridDim.y * gridDim.z;
    unsigned sum, cnt, mine, sp = 0u;
    for (;;) {
        sum = 0u; cnt = 0u; mine = 0u;
#pragma unroll
        for (unsigned j = 0; j < 16; ++j) { const unsigned c = xb_ld(&bar[XB_XCNT(j)]); sum += c; cnt += (c > 0u) ? 1u : 0u; mine = (j == x) ? c : mine; }
        if (sum == G) break;
        __builtin_amdgcn_s_sleep(1);
        if ((++sp & 255u) == 0u) { if (xb_ld(&bar[XB_TMO])) break; if (sp > XB_SPIN_CAP) { atomicAdd(&bar[XB_TMO], 1u); break; } }
    }
    nloc = mine > 0u ? mine : 1u; nx = cnt > 0u ? cnt : 1u;
}
__device__ __forceinline__ void xcd_barrier(const XcdBarrier& b) {
    asm volatile("s_waitcnt vmcnt(0)" ::: "memory");
    __syncthreads();
    if (b.w0 && hw_lane() == 0) {
        unsigned* bar = b.bar;
        __builtin_amdgcn_s_waitcnt(0);
        unsigned nloc = b.st[0], nx = b.st[1];
        if (nloc == 0u) { xcd_barrier_complete(bar, b.x, nloc, nx); b.st[0] = nloc; b.st[1] = nx; }
        const unsigned old = xb_add(&bar[XB_XSUB(b.x)], 1u);
        const unsigned gen = old / nloc;
        if (old + 1u == (gen + 1u) * nloc) {
            __builtin_amdgcn_fence(__ATOMIC_RELEASE, "agent");
            asm volatile("s_waitcnt vmcnt(0)" ::: "memory");
            const unsigned og = xb_add(&bar[XB_TOP], 1u);
            const unsigned tg = og / nx;
            if (og + 1u == (tg + 1u) * nx) xb_add(&bar[XB_TOPGEN], 1u);
            else XB_SPIN(xb_ld(&bar[XB_TOPGEN]) == tg, bar);
            __builtin_amdgcn_fence(__ATOMIC_ACQUIRE, "agent");
            xb_add(&bar[XB_XGEN(b.x)], 1u);
            asm volatile("s_waitcnt vmcnt(0)" ::: "memory");
        } else {
            XB_SPIN(xb_ld(&bar[XB_XGEN(b.x)]) == gen, bar);
            __builtin_amdgcn_fence(__ATOMIC_ACQUIRE, "agent");
            asm volatile("s_waitcnt vmcnt(0)" ::: "memory");
        }
    }
    __syncthreads();
}

struct Args { const float* in[29]; float* out; unsigned char* ws; int ph_lo, ph_hi; };
struct Ctx {
    LAS unsigned char* lds;
    int G, bid, wave;
    const float* const* in; GAS float* out; GAS unsigned char* ws;
};
#define WSP(T, off) ((T*)(GAS T*)(C.ws + (off)))
__device__ __forceinline__ const float* inp_(const float* const* in, int k) { asm volatile("" : "+s"(k)); return (const float*)(const GAS float*)in[k]; }
#define INP(k) inp_(C.in, (k))
#define OUTP ((float*)C.out)
__device__ __forceinline__ bool fresh(Ctx& C) { asm volatile("" : "+s"(C.ws), "+s"(C.out)); return true; }

__device__ __forceinline__ void row_bt(int row, bool& smp, int& b, int& t) { smp = row >= MP; if (!smp) { b = row >> 12; t = row & (SEQ - 1); } else { const int r = row - MP; b = r >> 2; t = r & 3; } }
__device__ __forceinline__ float row_rinv(const float* ss, int row) {
    const f32x4* p = (const f32x4*)(ss + (size_t)row * 16); const f32x4 a = p[0], b = p[1], c = p[2], d = p[3];
    const float s = ((a.x + a.y) + (a.z + a.w)) + ((b.x + b.y) + (b.z + b.w)) + ((c.x + c.y) + (c.z + c.w)) + ((d.x + d.y) + (d.z + d.w));
    return __builtin_amdgcn_rsqf(s * (1.0f / D) + EPS);
}

struct EpiIn {
    static constexpr bool RINV = true, SUMSQ = false, FENCE_QUAD = false; static constexpr int FENCE_ROWS = 1;
    const float* ss; float* ss_out; f16* gg; f16* xb; float* pconv; float* sconv;
    __device__ __forceinline__ float quad(int row, int col, f32x4 v, float rinv) const {
        v *= rinv;
        if (col < D) { f32x4 g; g.x = gelu_tanh(v.x); g.y = gelu_tanh(v.y); g.z = gelu_tanh(v.z); g.w = gelu_tanh(v.w); *(h4*)(gg + (size_t)row * D + col) = cvt_h4(g); }
        else { const int c = col - D; *(h4*)(xb + (size_t)row * D + c) = cvt_h4(v);
            bool smp; int b, t; row_bt(row, smp, b, t);
            if (!smp) { if (t >= SEQ - 3) *(f32x4*)(pconv + ((size_t)b * 3 + (t - (SEQ - 3))) * D + c) = v; }
            else { if (t >= 1) *(f32x4*)(sconv + ((size_t)b * 3 + (t - 1)) * D + c) = v; } }
        return 0.f;
    }
};
struct EpiGate {
    static constexpr bool RINV = false, SUMSQ = false, FENCE_QUAD = true; static constexpr int FENCE_ROWS = 1;
    const float* ss; float* ss_out; const float* rb; const float* ib; const float* lam; const f16* xc; float* la; float* ix;
    __device__ __forceinline__ float quad(int row, int col, f32x4 v, float) const {
        const int blk = col >> 9, ri = (col >> 8) & 1, ch = blk * 256 + (col & 255);
        if (ri == 0) { const f32x4 bb = *(const f32x4*)(rb + ch), lm = *(const f32x4*)(lam + ch); f32x4 o;
            o.x = sigmoidf_(v.x + bb.x) * lm.x; o.y = sigmoidf_(v.y + bb.y) * lm.y; o.z = sigmoidf_(v.z + bb.z) * lm.z; o.w = sigmoidf_(v.w + bb.w) * lm.w;
            *(f32x4*)(la + (size_t)row * D + ch) = o; }
        else { const f32x4 bb = *(const f32x4*)(ib + ch); const f32x4 x = cvt_f4(*(const h4*)(xc + (size_t)row * D + ch)); f32x4 o;
            o.x = sigmoidf_(v.x + bb.x) * x.x; o.y = sigmoidf_(v.y + bb.y) * x.y; o.z = sigmoidf_(v.z + bb.z) * x.z; o.w = sigmoidf_(v.w + bb.w) * x.w;
            *(f32x4*)(ix + (size_t)row * D + ch) = o; }
        return 0.f;
    }
};
struct EpiRes {
    static constexpr bool RINV = false, SUMSQ = true, FENCE_QUAD = false; static constexpr int FENCE_ROWS = 8;
    const float* ss; float* ss_out; const float* xin_p; const float* xin_s; float* xout; f16* xh;
    __device__ __forceinline__ float quad(int row, int col, f32x4 v, float) const {
        f32x4 xo;
        if (xin_p) xo = *(const f32x4*)(row < MP ? xin_p + (size_t)row * D + col : xin_s + (size_t)(row - MP) * D + col);
        else xo = cvt_f4(*(const h4*)(xh + (size_t)row * D + col));
        const f32x4 xn = xo + v;
        if (xout) __builtin_nontemporal_store(xn, (f32x4*)(xout + (size_t)row * D + col)); else *(h4*)(xh + (size_t)row * D + col) = cvt_h4(xn);
        return (xn.x * xn.x + xn.y * xn.y) + (xn.z * xn.z + xn.w * xn.w);
    }
    __device__ __forceinline__ float oct(int row, int col, f32x4 v0, f32x4 v1, float) const {
        f32x4 x0, x1;
        if (xin_p) { const float* p = xin_p + (size_t)row * D + col; x0 = *(const f32x4*)p; x1 = *(const f32x4*)(p + 4); }
        else { const h8 h = *(const h8*)(xh + (size_t)row * D + col); x0 = (f32x4){(float)h[0], (float)h[1], (float)h[2], (float)h[3]}; x1 = (f32x4){(float)h[4], (float)h[5], (float)h[6], (float)h[7]}; }
        x0 += v0; x1 += v1;
        if (xout) { float* q = xout + (size_t)row * D + col; __builtin_nontemporal_store(x0, (f32x4*)q); __builtin_nontemporal_store(x1, (f32x4*)(q + 4)); }
        else { const h4 a = cvt_h4(x0), c = cvt_h4(x1); *(h8*)(xh + (size_t)row * D + col) = (h8){a.x, a.y, a.z, a.w, c.x, c.y, c.z, c.w}; }
        return ((x0.x * x0.x + x0.y * x0.y) + (x0.z * x0.z + x0.w * x0.w)) + ((x1.x * x1.x + x1.y * x1.y) + (x1.z * x1.z + x1.w * x1.w));
    }
};
struct EpiUp {
    static constexpr bool RINV = true, SUMSQ = false, FENCE_QUAD = false; static constexpr int FENCE_ROWS = 1;
    const float* ss; float* ss_out; f16* g; f16* v; float* pffn; float* sffn;
    __device__ __forceinline__ float quad(int row, int col, f32x4 a, float rinv) const {
        a *= rinv;
        if (col < DFF) { *(h4*)(g + (size_t)row * DFF + col) = cvt_h4(a);
            bool smp; int b, t; row_bt(row, smp, b, t);
            if (!smp) { if (t >= SEQ - 2) *(f32x4*)(pffn + ((size_t)b * 2 + (t - (SEQ - 2))) * DFF + col) = a; }
            else { if (t >= 2) *(f32x4*)(sffn + ((size_t)b * 2 + (t - 2)) * DFF + col) = a; } }
        else *(h4*)(v + (size_t)row * DFF + (col - DFF)) = cvt_h4(a);
        return 0.f;
    }
};
struct EpiRaw {
    static constexpr bool RINV = true, SUMSQ = false, FENCE_QUAD = false; static constexpr int FENCE_ROWS = 1;
    const float* ss; float* ss_out; float* raw; int ld;
    __device__ __forceinline__ float quad(int row, int col, f32x4 a, float rinv) const { *(f32x4*)(raw + (size_t)row * ld + col) = a * rinv; return 0.f; }
};
__device__ __forceinline__ float lane_rinv(const float* ss, int row, int fq) {
    const f32x4 p = *(const f32x4*)(ss + (size_t)row * 16 + 4 * fq); float s = (p.x + p.y) + (p.z + p.w);
    s += __shfl_xor(s, 16); s += __shfl_xor(s, 32); return __builtin_amdgcn_rsqf(s * (1.0f / D) + EPS);
}
template <class E> struct Pg8Epi {
    E e;
    __device__ __forceinline__ void operator()(const f32x4 (&acc)[2][2][4][2], const pg8::Unit& u, int wr, int wc, int fr, int fq) const {
        const int row0 = u.pm * 256 + wr * 64 + fr, col0 = u.pn * 256 + wc * 32 + 8 * fq;
        f32x4 ssp[2][4];
        if (E::RINV) {
#pragma unroll
            for (int ai = 0; ai < 2; ++ai)
#pragma unroll
                for (int m = 0; m < 4; ++m) ssp[ai][m] = *(const f32x4*)(e.ss + (size_t)(row0 + ai * 128 + m * 16) * 16 + 4 * fq);
        }
#pragma unroll
        for (int ai = 0; ai < 2; ++ai)
#pragma unroll
            for (int m = 0; m < 4; ++m) {
                const int row = row0 + ai * 128 + m * 16;
                float rinv = 1.0f;
                if (E::RINV) { float sq = (ssp[ai][m].x + ssp[ai][m].y) + (ssp[ai][m].z + ssp[ai][m].w); sq += __shfl_xor(sq, 16); sq += __shfl_xor(sq, 32); rinv = __builtin_amdgcn_rsqf(sq * (1.0f / D) + EPS); }
                float s = 0.f;
#pragma unroll
                for (int bj = 0; bj < 2; ++bj)
                    s += e.oct(row, col0 + bj * 128, acc[ai][bj][m][0], acc[ai][bj][m][1], rinv);
                if (E::SUMSQ) { s += __shfl_xor(s, 16); s += __shfl_xor(s, 32); if (fq == 0) e.ss_out[(size_t)row * 16 + u.pn * 4 + wc] = s; }
                if ((m & (E::FENCE_ROWS - 1)) == E::FENCE_ROWS - 1) asm volatile("" ::: "memory");
            }
    }
};

constexpr int MINI_T_OFF = 65536;
__device__ __forceinline__ float dpp_dummy_() { return 0.f; }
template <int K> struct MiniPre { static constexpr int KS32 = K / 8 / 32, NB = KS32 < 4 ? KS32 : 4; h8 fa[NB][2], fb[NB][4]; f32x4 ssn[4]; bool valid; };
#define MINI_KOFS(s_) (NB >= 2 ? ((s_) >> 1) * 64 + 16 * lq + 8 * ((s_) & 1) : (s_) * 32 + 8 * lq)
#define MINI_LOAD(uu, k0, a, b) do { const int rb_ = (uu) & 15, x_ = (uu) >> 4; \
        const GAS f16* ap_ = (const GAS f16*)A + (size_t)(MP + 32 * rb_ + l15) * lda + me.acol(x_) + w * ks + (k0) * 32; \
        _Pragma("unroll") for (int c_ = 0; c_ < 4; ++c_) { const GAS f16* bp_ = (const GAS f16*)Bt + (size_t)(me.brow(x_, c_) + l15) * ldb + w * ks + (k0) * 32; \
            _Pragma("unroll") for (int s_ = 0; s_ < NB; ++s_) b[s_][c_] = *(const GAS h8*)(bp_ + MINI_KOFS(s_)); } \
        _Pragma("unroll") for (int s_ = 0; s_ < NB; ++s_) _Pragma("unroll") for (int r_ = 0; r_ < 2; ++r_) a[s_][r_] = *(const GAS h8*)(ap_ + (size_t)(16 * r_) * lda + MINI_KOFS(s_)); } while (0)
#define MINI_SS(uu, dst) do { if (ME::RINV) { const GAS f32x4* sp_ = (const GAS f32x4*)(me.ss + (size_t)(MP + 32 * ((uu) & 15) + prow) * 16); dst[0] = sp_[0]; dst[1] = sp_[1]; dst[2] = sp_[2]; dst[3] = sp_[3]; } } while (0)
template <class ME, int K>
__device__ __forceinline__ void mini_prefetch(Ctx& C, const f16* A, int lda, const f16* Bt, int ldb, const ME& me, MiniPre<K>& pre) {
    const int tid_o = opq_tid(), lane = tid_o & 63, w = __builtin_amdgcn_readfirstlane(tid_o >> 6), l15 = lane & 15, lq = lane >> 4, prow = tid_o >> 4;
    constexpr int ks = K / 8, KS32 = ks / 32, NB = KS32 < 4 ? KS32 : 4;
    const int u = (C.G & 7) == 0 ? (C.bid & 7) * (C.G >> 3) + (C.bid >> 3) : C.bid;
    if (u < me.nunits()) { MINI_LOAD(u, 0, pre.fa, pre.fb); MINI_SS(u, pre.ssn); pre.valid = true; }
}
template <class ME, int K> struct MiniPost { Ctx* C; const f16* A; int lda; const f16* Bt; int ldb; const ME* me; MiniPre<K>* pre;
    __device__ __forceinline__ void operator()() const { mini_prefetch<ME, K>(*C, A, lda, Bt, ldb, *me, *pre); } };
template <class ME, int K>
__device__ __forceinline__ void mini_gemm(Ctx& C, const f16* A, int lda, const f16* Bt, int ldb, const ME& me, const MiniPre<K>* pre = nullptr) {
    const int tid_o = opq_tid(), lane_o = tid_o & 63, wave_o = __builtin_amdgcn_readfirstlane(tid_o >> 6);
    LAS float* P = (LAS float*)C.lds;
    LAS float* T = (LAS float*)(C.lds + MINI_T_OFF);
    constexpr int ks = K / 8, KS32 = ks / 32, NB = KS32 < 4 ? KS32 : 4;
    const int lane = lane_o, w = wave_o, nunits = me.nunits(), l15 = lane & 15, lq = lane >> 4;
    const int prow = tid_o >> 4, pcq = (tid_o & 15) * 4;
    for (int rmm = 0; rmm <= ((((REP_MASK >> 21) & 1u) && ME::IDEM) ? REP_N : 0); ++rmm) {
    int u = (C.G & 7) == 0 ? (C.bid & 7) * (C.G >> 3) + (C.bid >> 3) : C.bid;
    h8 fa[NB][2], fb[NB][4]; f32x4 ssn[4];
    if (pre && pre->valid && rmm == 0) {
#pragma unroll
        for (int s_ = 0; s_ < NB; ++s_) { fa[s_][0] = pre->fa[s_][0]; fa[s_][1] = pre->fa[s_][1]; fb[s_][0] = pre->fb[s_][0]; fb[s_][1] = pre->fb[s_][1]; fb[s_][2] = pre->fb[s_][2]; fb[s_][3] = pre->fb[s_][3]; }
        ssn[0] = pre->ssn[0]; ssn[1] = pre->ssn[1]; ssn[2] = pre->ssn[2]; ssn[3] = pre->ssn[3];
    } else if (u < nunits) { MINI_LOAD(u, 0, fa, fb); MINI_SS(u, ssn); }
    for (; u < nunits; u += C.G) {
        const int rb = u & 15, x = u >> 4, un = u + C.G;
        float rinv = 1.0f;
        f32x4 acc[2][4];
#pragma unroll
        for (int r = 0; r < 2; ++r)
#pragma unroll
            for (int c = 0; c < 4; ++c) acc[r][c] = (f32x4){0.f, 0.f, 0.f, 0.f};
#pragma unroll
        for (int sI = 0; sI < NB; ++sI)
#pragma unroll
            for (int r = 0; r < 2; ++r)
#pragma unroll
                for (int c = 0; c < 4; ++c) acc[r][c] = __builtin_amdgcn_mfma_f32_16x16x32_f16(fb[sI][c], fa[sI][r], acc[r][c], 0, 0, 0);
        if (ME::RINV) { const f32x4 q = (ssn[0] + ssn[1]) + (ssn[2] + ssn[3]); rinv = __builtin_amdgcn_rsqf(((q.x + q.y) + (q.z + q.w)) * (1.0f / D) + EPS); }
#pragma unroll
        for (int k0 = NB; k0 < KS32; k0 += NB) {
            MINI_LOAD(u, k0, fa, fb);
#pragma unroll
            for (int sI = 0; sI < NB; ++sI)
#pragma unroll
                for (int r = 0; r < 2; ++r)
#pragma unroll
                    for (int c = 0; c < 4; ++c) acc[r][c] = __builtin_amdgcn_mfma_f32_16x16x32_f16(fb[sI][c], fa[sI][r], acc[r][c], 0, 0, 0);
        }
        if (KS32 <= NB) { if (un < nunits) { MINI_LOAD(un, 0, fa, fb); MINI_SS(un, ssn); } }
#pragma unroll
        for (int r = 0; r < 2; ++r)
#pragma unroll
            for (int c = 0; c < 4; ++c) *(LAS f32x4*)(P + (w * 32 + 16 * r + l15) * 64 + 16 * c + 4 * lq) = acc[r][c];
        __syncthreads();
        {
            f32x4 v = (f32x4){0.f, 0.f, 0.f, 0.f};
#pragma unroll
            for (int ww = 0; ww < 8; ++ww) v += *(const LAS f32x4*)(P + (ww * 32 + prow) * 64 + pcq);
            if (ME::RINV) v *= rinv;
            *(LAS f32x4*)(T + prow * 64 + pcq) = v;
        }
        __syncthreads();
        me.tile(rb, x, T, tid_o);
        if (KS32 > NB) { if (un < nunits) { MINI_LOAD(un, 0, fa, fb); MINI_SS(un, ssn); } }
    }
    __syncthreads();
    }
}
#undef MINI_LOAD
#undef MINI_KOFS
#undef MINI_SS
template <class ME, int K>
__device__ __forceinline__ void mini_gemm64(Ctx& C, const f16* A, int lda, const f16* Bt, int ldb, const ME& me) {
    const int tid_o = opq_tid(), lane_o = tid_o & 63, wave_o = __builtin_amdgcn_readfirstlane(tid_o >> 6);
    LAS float* P = (LAS float*)C.lds;
    LAS float* T = (LAS float*)(C.lds + MINI_T_OFF);
    constexpr int ks = K / 4, KS32 = ks / 32, NB = KS32 < 4 ? KS32 : 4;
    const int lane = lane_o, w = wave_o, kq = w & 3, rh = w >> 2, nunits = me.nunits() >> 1, l15 = lane & 15, lq = lane >> 4;
    const int prow = tid_o >> 4, pcq = (tid_o & 15) * 4;
#define M64_KOFS(s_) (((s_) >> 1) * 64 + 16 * lq + 8 * ((s_) & 1))
#define M64_LOAD(uu, k0, a, b) do { const int rb_ = (uu) & 7, x_ = (uu) >> 3; \
        const GAS f16* ap_ = (const GAS f16*)A + (size_t)(MP + 64 * rb_ + 32 * rh + l15) * lda + me.acol(x_) + kq * ks + (k0) * 32; \
        _Pragma("unroll") for (int c_ = 0; c_ < 4; ++c_) { const GAS f16* bp_ = (const GAS f16*)Bt + (size_t)(me.brow(x_, c_) + l15) * ldb + kq * ks + (k0) * 32; \
            _Pragma("unroll") for (int s_ = 0; s_ < NB; ++s_) b[s_][c_] = *(const GAS h8*)(bp_ + M64_KOFS(s_)); } \
        _Pragma("unroll") for (int s_ = 0; s_ < NB; ++s_) _Pragma("unroll") for (int r_ = 0; r_ < 2; ++r_) a[s_][r_] = *(const GAS h8*)(ap_ + (size_t)(16 * r_) * lda + M64_KOFS(s_)); } while (0)
#define M64_SS(uu, dst) do { if (ME::RINV) { _Pragma("unroll") for (int i_ = 0; i_ < 2; ++i_) { const GAS f32x4* sp_ = (const GAS f32x4*)(me.ss + (size_t)(MP + 64 * ((uu) & 7) + 32 * i_ + prow) * 16); \
        dst[i_][0] = sp_[0]; dst[i_][1] = sp_[1]; dst[i_][2] = sp_[2]; dst[i_][3] = sp_[3]; } } } while (0)
#define M64_MMA(a, b) do { _Pragma("unroll") for (int s_ = 0; s_ < NB; ++s_) _Pragma("unroll") for (int r_ = 0; r_ < 2; ++r_) _Pragma("unroll") for (int c_ = 0; c_ < 4; ++c_) \
        acc[r_][c_] = __builtin_amdgcn_mfma_f32_16x16x32_f16(b[s_][c_], a[s_][r_], acc[r_][c_], 0, 0, 0); } while (0)
    int u = (C.G & 7) == 0 ? (C.bid & 7) * (C.G >> 3) + (C.bid >> 3) : C.bid;
    h8 fa[NB][2], fb[NB][4]; f32x4 ssn[2][4];
    if (u < nunits) { M64_LOAD(u, 0, fa, fb); M64_SS(u, ssn); }
    for (; u < nunits; u += C.G) {
        const int rb = u & 7, x = u >> 3, un = u + C.G;
        float rinv0 = 1.0f, rinv1 = 1.0f;
        f32x4 acc[2][4];
#pragma unroll
        for (int r = 0; r < 2; ++r)
#pragma unroll
            for (int c = 0; c < 4; ++c) acc[r][c] = (f32x4){0.f, 0.f, 0.f, 0.f};
        M64_MMA(fa, fb);
        if (ME::RINV) { const f32x4 q0 = (ssn[0][0] + ssn[0][1]) + (ssn[0][2] + ssn[0][3]), q1 = (ssn[1][0] + ssn[1][1]) + (ssn[1][2] + ssn[1][3]);
            rinv0 = __builtin_amdgcn_rsqf(((q0.x + q0.y) + (q0.z + q0.w)) * (1.0f / D) + EPS); rinv1 = __builtin_amdgcn_rsqf(((q1.x + q1.y) + (q1.z + q1.w)) * (1.0f / D) + EPS); }
#pragma unroll
        for (int k0 = NB; k0 < KS32; k0 += NB) { M64_LOAD(u, k0, fa, fb); M64_MMA(fa, fb); }
        if (un < nunits) { M64_LOAD(un, 0, fa, fb); M64_SS(un, ssn); }
#pragma unroll
        for (int r = 0; r < 2; ++r)
#pragma unroll
            for (int c = 0; c < 4; ++c) *(LAS f32x4*)(P + (w * 32 + 16 * r + l15) * 64 + 16 * c + 4 * lq) = acc[r][c];
        __syncthreads();
#pragma unroll
        for (int i = 0; i < 2; ++i) {
            f32x4 v = (f32x4){0.f, 0.f, 0.f, 0.f};
#pragma unroll
            for (int q4 = 0; q4 < 4; ++q4) v += *(const LAS f32x4*)(P + ((4 * i + q4) * 32 + prow) * 64 + pcq);
            if (ME::RINV) v *= (i == 0 ? rinv0 : rinv1);
            *(LAS f32x4*)(T + (32 * i + prow) * 64 + pcq) = v;
        }
        __syncthreads();
        me.tile(2 * rb, x, T, tid_o); me.tile(2 * rb + 1, x, T + 32 * 64, tid_o);
    }
    __syncthreads();
#undef M64_KOFS
#undef M64_LOAD
#undef M64_SS
#undef M64_MMA
}
template <class E> struct MiniQuad {
    static constexpr bool RINV = E::RINV, IDEM = !E::SUMSQ;
    const float* ss; E e; int N; int a_pn_bytes;
    __device__ __forceinline__ int nunits() const { return 16 * (N / 64); }
    __device__ __forceinline__ int acol(int x) const { return ((x * 64) >> 9) * (a_pn_bytes >> 1); }
    __device__ __forceinline__ int brow(int x, int c) const { return 64 * x + 16 * c; }
    __device__ __forceinline__ void tile(int rb, int x, LAS float* T, int tid) const {
        const int row = tid >> 4, cq = (tid & 15) * 4;
        const f32x4 v = *(const LAS f32x4*)(T + row * 64 + cq);
        const int grow = MP + 32 * rb + row;
        float s = e.quad(grow, 64 * x + cq, v, 1.0f);
        if (E::SUMSQ) { s += __shfl_xor(s, 1); s += __shfl_xor(s, 2); s += __shfl_xor(s, 4); s += __shfl_xor(s, 8); if ((tid & 15) == 0) e.ss_out[(size_t)grow * 16 + x] = s; }
    }
};

constexpr int DUMP_OFF = LDS_BYTES - 2048;
__device__ __forceinline__ void warm_panel(Ctx& C, const void* p, size_t bytes) {
    const int tid = opq_tid();
    const size_t nl = bytes >> 7, step = (size_t)C.G * (NWAVES * 64);
    for (size_t l0 = (size_t)C.bid * (NWAVES * 64); l0 < nl; l0 += step) {
        size_t l = l0 + tid; if (l >= nl) l = nl - 1;
        __builtin_amdgcn_global_load_lds((const unsigned*)((const char*)p + (l << 7)), (LAS unsigned*)(C.lds + DUMP_OFF + C.wave * 256), 4, 0, 0);
    }
}
template <class E, int K>
__device__ __forceinline__ void gemm_both(Ctx& C, const f16* A, int lda, const f16* Bt, int ldb, int N, int a_pn_bytes, const E& e, const E& edry, const void* warm = nullptr, size_t warm_bytes = 0) {
    pg8::Gemm g{A, Bt, lda, ldb, MP, N, K, a_pn_bytes, C.wave}; pg8::StaticOrder S; S.init(MP, N, C.G, C.bid);
    Pg8Epi<E> pe{e};
    MiniQuad<E> me0{e.ss, e, N, a_pn_bytes}; MiniPre<K> pre; pre.valid = false;
    MiniPost<MiniQuad<E>, K> post{&C, A, lda, Bt, ldb, &me0, &pre};
    pg8::gemm_phase<Pg8Epi<E>, MiniPost<MiniQuad<E>, K>>(C.lds, g, S, pe, post);
    VM_WAIT(); __syncthreads();
    if (warm) warm_panel(C, warm, warm_bytes);
    for (int rm = 0; rm <= (((REP_MASK >> 20) & 1u) ? REP_N : 0); ++rm) { MiniQuad<E> me{e.ss, rm == 0 ? e : edry, N, a_pn_bytes}; mini_gemm<MiniQuad<E>, K>(C, A, lda, Bt, ldb, me, rm == 0 ? &pre : nullptr); }
}

__device__ __forceinline__ float dpp_ror1(float v) { return __builtin_bit_cast(float, __builtin_amdgcn_update_dpp(0, __builtin_bit_cast(int, v), 0x121, 0xf, 0xf, false)); }
__device__ __forceinline__ float dpp_ror2(float v) { return __builtin_bit_cast(float, __builtin_amdgcn_update_dpp(0, __builtin_bit_cast(int, v), 0x122, 0xf, 0xf, false)); }
__device__ __forceinline__ float dpp_ror3(float v) { return __builtin_bit_cast(float, __builtin_amdgcn_update_dpp(0, __builtin_bit_cast(int, v), 0x123, 0xf, 0xf, false)); }
__device__ __forceinline__ f32x4 ror1(f32x4 v) { return (f32x4){dpp_ror1(v.x), dpp_ror1(v.y), dpp_ror1(v.z), dpp_ror1(v.w)}; }
__device__ __forceinline__ f32x4 ror2(f32x4 v) { return (f32x4){dpp_ror2(v.x), dpp_ror2(v.y), dpp_ror2(v.z), dpp_ror2(v.w)}; }
__device__ __forceinline__ f32x4 ror3(f32x4 v) { return (f32x4){dpp_ror3(v.x), dpp_ror3(v.y), dpp_ror3(v.z), dpp_ror3(v.w)}; }
__device__ __forceinline__ f32x4 sel4(bool c, f32x4 a, f32x4 b) { return (f32x4){c ? a.x : b.x, c ? a.y : b.y, c ? a.z : b.z, c ? a.w : b.w}; }
template <int K> __device__ __forceinline__ float dppf_ror(float v) { return __builtin_bit_cast(float, __builtin_amdgcn_update_dpp(0, __builtin_bit_cast(int, v), 0x120 + K, 0xf, 0xf, true)); }
template <int K> __device__ __forceinline__ float dppf_shr_old(float old, float v) { return __builtin_bit_cast(float, __builtin_amdgcn_update_dpp(__builtin_bit_cast(int, old), __builtin_bit_cast(int, v), 0x110 + K, 0xf, 0xf, false)); }
template <int K> __device__ __forceinline__ f32x4 tap_prev(f32x4 gprev, f32x4 g) {
    return (f32x4){dppf_shr_old<K>(dppf_ror<K>(gprev.x), g.x), dppf_shr_old<K>(dppf_ror<K>(gprev.y), g.y), dppf_shr_old<K>(dppf_ror<K>(gprev.z), g.z), dppf_shr_old<K>(dppf_ror<K>(gprev.w), g.w)}; }
template <int K> __device__ __forceinline__ f32x4 tap_first(f32x4 halo_lanes, f32x4 g) {
    return (f32x4){dppf_shr_old<K>(halo_lanes.x, g.x), dppf_shr_old<K>(halo_lanes.y, g.y), dppf_shr_old<K>(halo_lanes.z, g.z), dppf_shr_old<K>(halo_lanes.w, g.w)}; }
struct EpiGeglu {
    const float* ss; const float* cw; const float* cb; f16* mid; float* sidef; float* sidel; float* pffn; LAS float* H;
    __device__ __forceinline__ void operator()(f32x4 (&acc)[2][2][4][2], const pg8::Unit& u, int wr, int wc, int fr, int fq) const {
        const int ch0 = 128 * u.pn + 32 * wc + 8 * fq, rowb = u.pm * 256 + wr * 64 + fr;
        const bool seq_first = (u.pm & 15) == 0, seq_last = (u.pm & 15) == 15;
        f32x4 ssp[2][4], w0[2], w1[2], w2[2], bb[2];
#pragma unroll
        for (int ai = 0; ai < 2; ++ai)
#pragma unroll
            for (int m = 0; m < 4; ++m) ssp[ai][m] = *(const f32x4*)(ss + (size_t)(rowb + ai * 128 + m * 16) * 16 + 4 * fq);
#pragma unroll
        for (int n = 0; n < 2; ++n) { w0[n] = *(const f32x4*)(cw + ch0 + 4 * n); w1[n] = *(const f32x4*)(cw + DFF + ch0 + 4 * n); w2[n] = *(const f32x4*)(cw + 2 * DFF + ch0 + 4 * n); bb[n] = *(const f32x4*)(cb + ch0 + 4 * n); }
#pragma unroll
        for (int ai = 0; ai < 2; ++ai)
#pragma unroll
            for (int m = 0; m < 4; ++m) {
                float sq = (ssp[ai][m].x + ssp[ai][m].y) + (ssp[ai][m].z + ssp[ai][m].w); sq += __shfl_xor(sq, 16); sq += __shfl_xor(sq, 32);
                const float rinv = __builtin_amdgcn_rsqf(sq * (1.0f / D) + EPS);
#pragma unroll
                for (int n = 0; n < 2; ++n) { acc[ai][0][m][n] *= rinv; acc[ai][1][m][n] *= rinv; }
            }
        if (fr >= 14) {
#pragma unroll
            for (int ai = 0; ai < 2; ++ai)
#pragma unroll
                for (int n = 0; n < 2; ++n) *(LAS f32x4*)(H + ((wc * 4 + (2 * ai + wr)) * 2 + (fr - 14)) * 32 + 4 * n + 8 * fq) = acc[ai][0][3][n];
            if (wr == 1) {
#pragma unroll
                for (int n = 0; n < 2; ++n) { float* dst = seq_last ? pffn + ((size_t)(u.pm >> 4) * 2 + (fr - 14)) * DFF : sidel + ((size_t)u.pm * 2 + (fr - 14)) * DFF; *(f32x4*)(dst + ch0 + 4 * n) = acc[1][0][3][n]; }
            }
        }
        if (!seq_first && wr == 0 && fr < 2) {
#pragma unroll
            for (int n = 0; n < 2; ++n) { float* dst = sidef + ((size_t)u.pm * 2 + fr) * (2 * DFF) + ch0 + 4 * n; *(f32x4*)dst = acc[0][0][0][n]; *(f32x4*)(dst + DFF) = acc[0][1][0][n]; }
        }
        asm volatile("s_waitcnt lgkmcnt(0)" ::: "memory"); __builtin_amdgcn_s_barrier(); asm volatile("" ::: "memory");
#pragma unroll
        for (int ai = 0; ai < 2; ++ai) {
            const int grp = 2 * ai + wr;
            f32x4 hl1[2], hl2[2];
#pragma unroll
            for (int n = 0; n < 2; ++n) {
                f32x4 h1 = (f32x4){0.f, 0.f, 0.f, 0.f}, h2 = h1;
                if (grp > 0 && fr < 2) { const LAS float* hp = H + ((wc * 4 + grp - 1) * 2) * 32 + 4 * n + 8 * fq; h2 = *(const LAS f32x4*)hp; h1 = *(const LAS f32x4*)(hp + 32); }
                hl1[n] = h1; hl2[n] = sel4(fr == 0, h2, h1);
            }
#pragma unroll
            for (int m = 0; m < 4; ++m) {
                const int row = rowb + ai * 128 + m * 16;
                const bool skip = !seq_first && grp == 0 && m == 0 && fr < 2;
                f32x4 o2[2];
#pragma unroll
                for (int n = 0; n < 2; ++n) {
                    const f32x4 g = acc[ai][0][m][n];
                    const f32x4 p1 = m == 0 ? tap_first<1>(hl1[n], g) : tap_prev<1>(acc[ai][0][m == 0 ? 0 : m - 1][n], g);
                    const f32x4 p2 = m == 0 ? tap_first<2>(hl2[n], g) : tap_prev<2>(acc[ai][0][m == 0 ? 0 : m - 1][n], g);
                    const f32x4 gc = bb[n] + w0[n] * p2 + w1[n] * p1 + w2[n] * g;
                    const f32x4 vv = acc[ai][1][m][n];
                    o2[n].x = gelu_tanh(gc.x) * vv.x; o2[n].y = gelu_tanh(gc.y) * vv.y; o2[n].z = gelu_tanh(gc.z) * vv.z; o2[n].w = gelu_tanh(gc.w) * vv.w;
                }
                if (!skip) { const h4 a = cvt_h4(o2[0]), c = cvt_h4(o2[1]); *(h8*)(mid + (size_t)row * DFF + ch0) = (h8){a.x, a.y, a.z, a.w, c.x, c.y, c.z, c.w}; }
            }
        }
    }
};
struct MiniGeglu {
    static constexpr bool RINV = true, IDEM = true;
    const float* ss; const float* cw; const float* cb; const float* st; f16* mid; float* sffn;
    __device__ __forceinline__ int nunits() const { return 16 * (DFF / 32); }
    __device__ __forceinline__ int acol(int) const { return 0; }
    __device__ __forceinline__ int brow(int x, int c) const { const int ch0 = 32 * x, r0 = 256 * (ch0 >> 7) + (ch0 & 127); return r0 + (c >> 1) * 128 + (c & 1) * 16; }
    __device__ __forceinline__ void tile(int rb, int x, LAS float* T, int tid) const {
        const int row = tid >> 4, cc = (tid & 15) * 2, srow = 32 * rb + row, b = srow >> 2, t = srow & 3, ch = 32 * x + cc;
        float o[2];
#pragma unroll
        for (int e = 0; e < 2; ++e) {
            float gc = cb[ch + e];
#pragma unroll
            for (int j = 0; j < 3; ++j) { const int tt = t - 2 + j; const float gv = tt >= 0 ? T[(row - 2 + j) * 64 + cc + e] : st[((size_t)b * 2 + (t + j)) * DFF + ch + e]; gc += cw[j * DFF + ch + e] * gv; }
            o[e] = gelu_tanh(gc) * T[row * 64 + 32 + cc + e];
            if (t >= 2) sffn[((size_t)b * 2 + (t - 2)) * DFF + ch + e] = T[row * 64 + cc + e];
        }
        const h2 hv = __builtin_convertvector((f32x2){o[0], o[1]}, h2);
        *(h2*)(mid + (size_t)(MP + srow) * DFF + ch) = hv;
    }
};
template <int K> __device__ __forceinline__ float dpp_shr(float v, float old) { return __builtin_bit_cast(float, __builtin_amdgcn_update_dpp(__builtin_bit_cast(int, old), __builtin_bit_cast(int, v), 0x110 + K, 0xf, 0xf, false)); }
template <int K> __device__ __forceinline__ float dpp_shr0(float v) { return __builtin_bit_cast(float, __builtin_amdgcn_update_dpp(0, __builtin_bit_cast(int, v), 0x110 + K, 0xf, 0xf, true)); }
__device__ __forceinline__ float bcast15(float v, int addr) { return __builtin_bit_cast(float, __builtin_amdgcn_ds_bpermute(addr, __builtin_bit_cast(int, v))); }
__device__ __forceinline__ void lru_au(float rpre, float ipre, float rbv, float ibv, float splv, float x, float& a, float& u) {
    const float la = splv * sigmoidf_(rpre + rbv); a = __expf(la);
    u = __builtin_amdgcn_sqrtf(__builtin_fmaf(-a, a, 1.0f)) * sigmoidf_(ipre + ibv) * x;
}
struct EpiScan {
    const float* rb; const float* ib; const float* spl; const f16* xc; f16* acum; f16* hloc; float* ca; float* chh; LAS float* X;
    __device__ __forceinline__ void operator()(f32x4 (&acc)[2][2][4][2], const pg8::Unit& u, int wr, int wc, int fr, int fq) const {
        const int ch0 = 128 * u.pn + 32 * wc + 8 * fq, rowb = u.pm * 256 + wr * 64 + fr;
        const int baddr = ((((fq << 4) | 15)) << 2);
        f32x4 rbv[2], ibv[2], spv[2];
#pragma unroll
        for (int n = 0; n < 2; ++n) { rbv[n] = *(const f32x4*)(rb + ch0 + 4 * n); ibv[n] = *(const f32x4*)(ib + ch0 + 4 * n); spv[n] = *(const f32x4*)(spl + ch0 + 4 * n); }
        h8 xv[2][4];
#pragma unroll
        for (int ai = 0; ai < 2; ++ai)
#pragma unroll
            for (int m = 0; m < 4; ++m) xv[ai][m] = *(const h8*)(xc + (size_t)(rowb + ai * 128 + m * 16) * D + ch0);
#pragma unroll
        for (int ai = 0; ai < 2; ++ai) {
#pragma unroll
            for (int m = 0; m < 4; ++m)
#pragma unroll
                for (int n = 0; n < 2; ++n) {
                    const f32x4 r4 = acc[ai][0][m][n], i4 = acc[ai][1][m][n]; const h8 xq = xv[ai][m];
                    const f32x4 x4 = n == 0 ? (f32x4){(float)xq[0], (float)xq[1], (float)xq[2], (float)xq[3]} : (f32x4){(float)xq[4], (float)xq[5], (float)xq[6], (float)xq[7]};
                    const f32x4 rb4 = rbv[n], ib4 = ibv[n], sp4 = spv[n];
                    float a0, a1, a2, a3, u0, u1, u2, u3;
                    lru_au(r4.x, i4.x, rb4.x, ib4.x, sp4.x, x4.x, a0, u0); lru_au(r4.y, i4.y, rb4.y, ib4.y, sp4.y, x4.y, a1, u1);
                    lru_au(r4.z, i4.z, rb4.z, ib4.z, sp4.z, x4.z, a2, u2); lru_au(r4.w, i4.w, rb4.w, ib4.w, sp4.w, x4.w, a3, u3);
                    acc[ai][0][m][n] = (f32x4){a0, a1, a2, a3}; acc[ai][1][m][n] = (f32x4){u0, u1, u2, u3};
                }
            asm volatile("" ::: "memory");
        }
#define SCAN16(av, hv) do { float as_, hs_; \
            as_ = dpp_shr<1>(av, 1.0f); hs_ = dpp_shr0<1>(hv); hv = av * hs_ + hv; av = as_ * av; \
            as_ = dpp_shr<2>(av, 1.0f); hs_ = dpp_shr0<2>(hv); hv = av * hs_ + hv; av = as_ * av; \
            as_ = dpp_shr<4>(av, 1.0f); hs_ = dpp_shr0<4>(hv); hv = av * hs_ + hv; av = as_ * av; \
            as_ = dpp_shr<8>(av, 1.0f); hs_ = dpp_shr0<8>(hv); hv = av * hs_ + hv; av = as_ * av; } while (0)
#pragma unroll
        for (int ai = 0; ai < 2; ++ai)
#pragma unroll
            for (int n = 0; n < 2; ++n)
#pragma unroll
                for (int j = 0; j < 4; j += 2) {
                    float PA0 = 1.0f, PH0 = 0.0f, PA1 = 1.0f, PH1 = 0.0f;
#pragma unroll
                    for (int m = 0; m < 4; ++m) {
                        float a0 = acc[ai][0][m][n][j], h0 = acc[ai][1][m][n][j], a1 = acc[ai][0][m][n][j + 1], h1 = acc[ai][1][m][n][j + 1];
                        SCAN16(a0, h0); SCAN16(a1, h1);
                        h0 = a0 * PH0 + h0; a0 = PA0 * a0; h1 = a1 * PH1 + h1; a1 = PA1 * a1;
                        acc[ai][0][m][n][j] = a0; acc[ai][1][m][n][j] = h0; acc[ai][0][m][n][j + 1] = a1; acc[ai][1][m][n][j + 1] = h1;
                        PA0 = bcast15(a0, baddr); PH0 = bcast15(h0, baddr); PA1 = bcast15(a1, baddr); PH1 = bcast15(h1, baddr);
                    }
                    if (fr == 0) { LAS float* xp = X + (((wc * 4 + (2 * ai + wr)) * 32) + 4 * n + 8 * fq + j) * 2; xp[0] = PA0; xp[1] = PH0; xp[2] = PA1; xp[3] = PH1; }
                }
#undef SCAN16
        asm volatile("s_waitcnt lgkmcnt(0)" ::: "memory"); __builtin_amdgcn_s_barrier(); asm volatile("" ::: "memory");
#pragma unroll
        for (int ai = 0; ai < 2; ++ai) {
            const int grp = 2 * ai + wr;
            f32x4 QA[2], QH[2];
#pragma unroll
            for (int n = 0; n < 2; ++n) {
                QA[n] = (f32x4){1.f, 1.f, 1.f, 1.f}; QH[n] = (f32x4){0.f, 0.f, 0.f, 0.f};
#pragma unroll
                for (int gp = 0; gp < 3; ++gp) {
                    const LAS float* xp = X + (((wc * 4 + gp) * 32) + 4 * n + 8 * fq) * 2;
                    const f32x4 t0 = *(const LAS f32x4*)xp, t1 = *(const LAS f32x4*)(xp + 4);
                    const bool use = gp < grp;
                    const f32x4 ga = use ? (f32x4){t0.x, t0.z, t1.x, t1.z} : (f32x4){1.f, 1.f, 1.f, 1.f}, gh = use ? (f32x4){t0.y, t0.w, t1.y, t1.w} : (f32x4){0.f, 0.f, 0.f, 0.f};
                    QH[n] = ga * QH[n] + gh; QA[n] = QA[n] * ga;
                }
            }
#pragma unroll
            for (int m = 0; m < 4; ++m) {
                f32x4 aa[2], hh2[2];
#pragma unroll
                for (int n = 0; n < 2; ++n) { const f32x4 a = acc[ai][0][m][n]; hh2[n] = a * QH[n] + acc[ai][1][m][n]; aa[n] = QA[n] * a; }
                const size_t o = (size_t)(rowb + ai * 128 + m * 16) * D + ch0;
                { const h4 a0 = cvt_h4(aa[0]), a1 = cvt_h4(aa[1]), h0 = cvt_h4(hh2[0]), h1 = cvt_h4(hh2[1]);
                  *(h8*)(acum + o) = (h8){a0.x, a0.y, a0.z, a0.w, a1.x, a1.y, a1.z, a1.w}; *(h8*)(hloc + o) = (h8){h0.x, h0.y, h0.z, h0.w, h1.x, h1.y, h1.z, h1.w}; }
                if (grp == 3 && m == 3 && fr == 15) {
#pragma unroll
                    for (int n = 0; n < 2; ++n) { *(f32x4*)(ca + (size_t)u.pm * D + ch0 + 4 * n) = aa[n]; *(f32x4*)(chh + (size_t)u.pm * D + ch0 + 4 * n) = hh2[n]; } }
            }
        }
    }
};
struct MiniScan {
    static constexpr bool RINV = false, IDEM = true;
    const float* ss; const float* rb; const float* ib; const float* spl; const f16* xc; const f16* gg; const float* h0; f16* y; float* sh;
    __device__ __forceinline__ int nunits() const { return 16 * (D / 32); }
    __device__ __forceinline__ int acol(int x) const { return ((32 * x) >> 8) * 256; }
    __device__ __forceinline__ int brow(int x, int c) const { const int ch0 = 32 * x, r0 = 256 * (ch0 >> 7) + (ch0 & 127); return r0 + (c >> 1) * 128 + (c & 1) * 16; }
    __device__ __forceinline__ void tile(int rb_, int x, LAS float* T, int tid) const {
        if (tid < 256) {
            const int sq = tid >> 5, c = tid & 31, ch = 32 * x + c, b = 8 * rb_ + sq;
            float h = h0[(size_t)b * D + ch];
            const float rbv = rb[ch], ibv = ib[ch], spv = spl[ch];
#pragma unroll
            for (int t = 0; t < 4; ++t) {
                const int row = 4 * sq + t; const size_t o = (size_t)(MP + 32 * rb_ + row) * D + ch;
                float a, uu; lru_au(T[row * 64 + c], T[row * 64 + 32 + c], rbv, ibv, spv, (float)xc[o], a, uu);
                h = a * h + uu; y[o] = (f16)(h * (float)gg[o]);
            }
            sh[(size_t)b * D + ch] = h;
        }
    }
};
__device__ __forceinline__ void y_apply(Ctx& C, int l) {
    const int tid_o = opq_tid();
    const f16* acum = WSP(f16, WS_LA); const f16* hloc = WSP(f16, WS_IX); const f16* gg = WSP(f16, WS_GG); f16* y = WSP(f16, WS_Y);
    const float* ca = WSP(float, WS_CA); const float* chh = WSP(float, WS_CH);
    LAS float* hin = (LAS float*)C.lds;
    for (int it = C.bid; it < 256; it += C.G) {
        const int pm = it >> 2, qd = it & 3, b = pm >> 4;
#pragma unroll
        for (int e = 0; e < 2; ++e) { const int ch = tid_o + 512 * e; float cav[15], chv[15]; const int np = pm - b * 16;
#pragma unroll
            for (int j = 0; j < 15; ++j) { const int jj = j < np ? b * 16 + j : b * 16; cav[j] = ca[(size_t)jj * D + ch]; chv[j] = chh[(size_t)jj * D + ch]; }
            float h = 0.f;
#pragma unroll
            for (int j = 0; j < 15; ++j) h = j < np ? cav[j] * h + chv[j] : h;
            hin[ch] = h; }
        __syncthreads();
        for (int i = tid_o; i < 64 * 128; i += 512) {
            const int row = pm * 256 + qd * 64 + (i >> 7), c8 = (i & 127) * 8; const size_t o = (size_t)row * D + c8;
            const h8 a8 = *(const h8*)(acum + o), h8v = *(const h8*)(hloc + o), g8 = *(const h8*)(gg + o);
            float hv[8]; h8 r;
#pragma unroll
            for (int e = 0; e < 8; ++e) { hv[e] = (float)a8[e] * hin[c8 + e] + (float)h8v[e]; r[e] = (f16)(hv[e] * (float)g8[e]); }
            *(h8*)(y + o) = r;
            if ((row & (SEQ - 1)) == SEQ - 1) {
#pragma unroll
                for (int e = 0; e < 8; ++e) OUTP[O_PH + ((size_t)l * BP + b) * D + c8 + e] = hv[e];
            }
        }
        __syncthreads();
    }
}

struct EpiKVQ {
    const float* ss; const float* rope; const float* kg; const float* qg; f16* kh; f16* vh; f16* qh; float* out; int mode;
    __device__ __forceinline__ void operator()(f32x4 (&acc)[2][2][4][2], const pg8::Unit& u, int wr, int wc, int fr, int fq) const {
        const int hd = 4 * u.pn + wc, rowb = u.pm * 256 + wr * 64 + fr;
        const bool isk = mode == 0 && hd < 8, isv = mode == 0 && hd >= 8 && hd < 16;
        const int qs = mode == 0 ? hd - 16 : hd, h = hd & 7;
        f32x4 ssp[2][4];
#pragma unroll
        for (int ai = 0; ai < 2; ++ai)
#pragma unroll
            for (int m = 0; m < 4; ++m) ssp[ai][m] = *(const f32x4*)(ss + (size_t)(rowb + ai * 128 + m * 16) * 16 + 4 * fq);
        f32x4 gn[2][2];
#pragma unroll
        for (int bj = 0; bj < 2; ++bj)
#pragma unroll
            for (int n = 0; n < 2; ++n) gn[bj][n] = isv ? (f32x4){1.f, 1.f, 1.f, 1.f} : *(const f32x4*)((isk ? kg : qg) + 32 * bj + 4 * n + 8 * fq);
#pragma unroll
        for (int ai = 0; ai < 2; ++ai)
#pragma unroll
            for (int m = 0; m < 4; ++m) {
                const int row = rowb + ai * 128 + m * 16; bool smp; int b, t; row_bt(row, smp, b, t);
                const int rpos = smp ? SEQ + t : t;
                float s0 = (ssp[ai][m].x + ssp[ai][m].y) + (ssp[ai][m].z + ssp[ai][m].w); s0 += __shfl_xor(s0, 16); s0 += __shfl_xor(s0, 32);
                const float rinv = __builtin_amdgcn_rsqf(s0 * (1.0f / D) + EPS);
                f32x4 v[2][2]; float sq = 0.f;
#pragma unroll
                for (int bj = 0; bj < 2; ++bj)
#pragma unroll
                    for (int n = 0; n < 2; ++n) { v[bj][n] = acc[ai][bj][m][n] * rinv; sq += (v[bj][n].x * v[bj][n].x + v[bj][n].y * v[bj][n].y) + (v[bj][n].z * v[bj][n].z + v[bj][n].w * v[bj][n].w); }
                sq += __shfl_xor(sq, 16); sq += __shfl_xor(sq, 32);
                if (!isv) {
                    const float rn = __builtin_amdgcn_rsqf(sq * (1.0f / HD) + EPS);
#pragma unroll
                    for (int bj = 0; bj < 2; ++bj)
#pragma unroll
                        for (int n = 0; n < 2; ++n) v[bj][n] = v[bj][n] * rn * gn[bj][n];
                }
                {
                    f32x4 p0, p1; p0.x = __shfl_xor(v[0][0].x, 16); p0.y = __shfl_xor(v[0][0].y, 16); p0.z = __shfl_xor(v[0][0].z, 16); p0.w = __shfl_xor(v[0][0].w, 16);
                    p1.x = __shfl_xor(v[0][1].x, 16); p1.y = __shfl_xor(v[0][1].y, 16); p1.z = __shfl_xor(v[0][1].z, 16); p1.w = __shfl_xor(v[0][1].w, 16);
                    if (!isv && fq < 2) {
                        const float* rp = rope + (size_t)rpos * 16;
                        const f32x4 c0 = *(const f32x4*)rp, c1 = *(const f32x4*)(rp + 4), s0 = *(const f32x4*)(rp + 8), s1 = *(const f32x4*)(rp + 12);
                        if (fq == 0) { v[0][0] = v[0][0] * c0 - p0 * s0; v[0][1] = v[0][1] * c1 - p1 * s1; }
                        else { v[0][0] = v[0][0] * c0 + p0 * s0; v[0][1] = v[0][1] * c1 + p1 * s1; }
                    }
                }
                if (isk || isv) {
                    f16* dst = (isk ? kh : vh) + (size_t)row * DKV + h * 64;
                    const bool cache = smp || t >= SEQ - 2048;
                    float* co = smp ? out + (isk ? O_SCK : O_SCV) + (((size_t)b * 4 + t) * NH + h) * HD : out + (isk ? O_PCK : O_PCV) + (((size_t)b * 2048 + (t - (SEQ - 2048))) * NH + h) * HD;
#pragma unroll
                    for (int bj = 0; bj < 2; ++bj) { const int dm = 32 * bj + 8 * fq; const h4 a = cvt_h4(v[bj][0]), c = cvt_h4(v[bj][1]);
                        *(h8*)(dst + dm) = (h8){a.x, a.y, a.z, a.w, c.x, c.y, c.z, c.w};
                        if (cache) { __builtin_nontemporal_store(v[bj][0], (f32x4*)(co + dm)); __builtin_nontemporal_store(v[bj][1], (f32x4*)(co + dm + 4)); } }
                } else {
                    f16* dst = qh + (size_t)row * 1536 + qs * 64;
#pragma unroll
                    for (int bj = 0; bj < 2; ++bj) { const h4 a = cvt_h4(v[bj][0] * 0.125f), c = cvt_h4(v[bj][1] * 0.125f);
                        *(h8*)(dst + 32 * bj + 8 * fq) = (h8){a.x, a.y, a.z, a.w, c.x, c.y, c.z, c.w}; }
                }
                asm volatile("" ::: "memory");
            }
    }
};
struct MiniKVQ {
    static constexpr bool RINV = true, IDEM = true;
    const float* ss; const float* rope; const float* kg; const float* qg; f16* kh; f16* vh; f16* qh; float* out; int mode;
    __device__ __forceinline__ int nunits() const { return 16 * (mode == 0 ? 40 : 24); }
    __device__ __forceinline__ int acol(int) const { return 0; }
    __device__ __forceinline__ int brow(int x, int c) const { return 256 * (x >> 2) + 32 * (x & 3) + 128 * (c >> 1) + 16 * (c & 1); }
    __device__ __forceinline__ void tile(int rb, int x, LAS float* T, int tid) const {
        const int rowl = tid >> 4, sub = tid & 15, srow = 32 * rb + rowl, b = srow >> 2, t = srow & 3;
        const bool isk = mode == 0 && x < 8, isv = mode == 0 && x >= 8 && x < 16; const int qs = mode == 0 ? x - 16 : x, h = x & 7;
        f32x4 v = *(const LAS f32x4*)(T + rowl * 64 + sub * 4);
        float s = (v.x * v.x + v.y * v.y) + (v.z * v.z + v.w * v.w);
        s += __shfl_xor(s, 1); s += __shfl_xor(s, 2); s += __shfl_xor(s, 4); s += __shfl_xor(s, 8);
        if (!isv) { const float rn = __builtin_amdgcn_rsqf(s * (1.0f / HD) + EPS); v = v * rn * *(const f32x4*)((isk ? kg : qg) + sub * 4); }
        f32x4 p; p.x = __shfl_xor(v.x, 2); p.y = __shfl_xor(v.y, 2); p.z = __shfl_xor(v.z, 2); p.w = __shfl_xor(v.w, 2);
        if (!isv && sub < 4) { const float* rp = rope + (size_t)(SEQ + t) * 16 + 4 * (sub & 1); const f32x4 cs = *(const f32x4*)rp, sn = *(const f32x4*)(rp + 8); v = sub < 2 ? v * cs - p * sn : v * cs + p * sn; }
        if (isk || isv) { *(h4*)((isk ? kh : vh) + (size_t)(MP + srow) * DKV + h * 64 + sub * 4) = cvt_h4(v); *(f32x4*)(out + (isk ? O_SCK : O_SCV) + ((size_t)srow * NH + h) * HD + sub * 4) = v; }
        else *(h4*)(qh + (size_t)(MP + srow) * 1536 + qs * 64 + sub * 4) = cvt_h4(v * 0.125f);
    }
};

struct EpiGateGelu {
    static constexpr bool RINV = true, SUMSQ = false, FENCE_QUAD = false; static constexpr int FENCE_ROWS = 1;
    const float* ss; float* ss_out; f16* gg;
    __device__ __forceinline__ float quad(int row, int col, f32x4 v, float rinv) const { v *= rinv; f32x4 g; g.x = gelu_tanh(v.x); g.y = gelu_tanh(v.y); g.z = gelu_tanh(v.z); g.w = gelu_tanh(v.w); *(h4*)(gg + (size_t)row * D + col) = cvt_h4(g); return 0.f; }
    __device__ __forceinline__ float oct(int row, int col, f32x4 v0, f32x4 v1, float rinv) const { v0 *= rinv; v1 *= rinv; f32x4 g0, g1; g0.x = gelu_tanh(v0.x); g0.y = gelu_tanh(v0.y); g0.z = gelu_tanh(v0.z); g0.w = gelu_tanh(v0.w); g1.x = gelu_tanh(v1.x); g1.y = gelu_tanh(v1.y); g1.z = gelu_tanh(v1.z); g1.w = gelu_tanh(v1.w);
        const h4 a = cvt_h4(g0), c = cvt_h4(g1); *(h8*)(gg + (size_t)row * D + col) = (h8){a.x, a.y, a.z, a.w, c.x, c.y, c.z, c.w}; return 0.f; }
};
struct EpiInConv {
    const float* ss; const float* cw; const float* cb; f16* xc; float* sidef; float* sidel; float* pconv; LAS float* H;
    __device__ __forceinline__ void operator()(f32x4 (&acc)[2][2][4][2], const pg8::Unit& u, int wr, int wc, int fr, int fq) const {
        const int rowb = u.pm * 256 + wr * 64 + fr;
        const int c0 = 256 * u.pn + 32 * wc + 8 * fq;
        const bool seq_first = (u.pm & 15) == 0, seq_last = (u.pm & 15) == 15;
        f32x4 ssp[2][4];
#pragma unroll
        for (int ai = 0; ai < 2; ++ai)
#pragma unroll
            for (int m = 0; m < 4; ++m) ssp[ai][m] = *(const f32x4*)(ss + (size_t)(rowb + ai * 128 + m * 16) * 16 + 4 * fq);
#pragma unroll
        for (int ai = 0; ai < 2; ++ai)
#pragma unroll
            for (int m = 0; m < 4; ++m) {
                float sq = (ssp[ai][m].x + ssp[ai][m].y) + (ssp[ai][m].z + ssp[ai][m].w); sq += __shfl_xor(sq, 16); sq += __shfl_xor(sq, 32);
                const float rinv = __builtin_amdgcn_rsqf(sq * (1.0f / D) + EPS);
#pragma unroll
                for (int bj = 0; bj < 2; ++bj)
#pragma unroll
                    for (int n = 0; n < 2; ++n) acc[ai][bj][m][n] *= rinv;
            }
        if (fr >= 13) {
#pragma unroll
            for (int ai = 0; ai < 2; ++ai)
#pragma unroll
                for (int bj = 0; bj < 2; ++bj)
#pragma unroll
                    for (int n = 0; n < 2; ++n) *(LAS f32x4*)(H + ((wc * 4 + (2 * ai + wr)) * 3 + (fr - 13)) * 64 + 32 * bj + 4 * n + 8 * fq) = acc[ai][bj][3][n];
            if (wr == 1) {
                float* dst = seq_last ? pconv + ((size_t)(u.pm >> 4) * 3 + (fr - 13)) * D : sidel + ((size_t)u.pm * 3 + (fr - 13)) * D;
#pragma unroll
                for (int bj = 0; bj < 2; ++bj)
#pragma unroll
                    for (int n = 0; n < 2; ++n) *(f32x4*)(dst + c0 + 128 * bj + 4 * n) = acc[1][bj][3][n];
            }
        }
        if (!seq_first && wr == 0 && fr < 3) {
#pragma unroll
            for (int bj = 0; bj < 2; ++bj)
#pragma unroll
                for (int n = 0; n < 2; ++n) *(f32x4*)(sidef + ((size_t)u.pm * 3 + fr) * D + c0 + 128 * bj + 4 * n) = acc[0][bj][0][n];
        }
        asm volatile("s_waitcnt lgkmcnt(0)" ::: "memory"); __builtin_amdgcn_s_barrier(); asm volatile("" ::: "memory");
#pragma unroll
        for (int bj = 0; bj < 2; ++bj) {
            f32x4 W0[2], W1[2], W2[2], W3[2], BB[2];
#pragma unroll
            for (int n = 0; n < 2; ++n) { const int ch = c0 + 128 * bj + 4 * n; W0[n] = *(const f32x4*)(cw + ch); W1[n] = *(const f32x4*)(cw + D + ch); W2[n] = *(const f32x4*)(cw + 2 * D + ch); W3[n] = *(const f32x4*)(cw + 3 * D + ch); BB[n] = *(const f32x4*)(cb + ch); }
#pragma unroll
            for (int n = 0; n < 2; ++n) {
                const int ch = c0 + 128 * bj + 4 * n;
                const f32x4 w0 = W0[n], w1 = W1[n], w2 = W2[n], w3 = W3[n], bb = BB[n];
#pragma unroll
                for (int ai = 0; ai < 2; ++ai) {
                    const int grp = 2 * ai + wr;
                    f32x4 h1 = (f32x4){0.f, 0.f, 0.f, 0.f}, h2 = h1, h3 = h1;
                    if (grp > 0 && fr < 3) { const LAS float* hp = H + ((wc * 4 + grp - 1) * 3) * 64 + 32 * bj + 4 * n + 8 * fq; h3 = *(const LAS f32x4*)hp; h2 = *(const LAS f32x4*)(hp + 64); h1 = *(const LAS f32x4*)(hp + 128); }
                    const f32x4 hl1 = h1, hl2 = sel4(fr == 0, h2, h1), hl3 = sel4(fr == 0, h3, sel4(fr == 1, h2, h1));
#pragma unroll
                    for (int m = 0; m < 4; ++m) {
                        const f32x4 x = acc[ai][bj][m][n], xp = acc[ai][bj][m == 0 ? 0 : m - 1][n];
                        const f32x4 p1 = m == 0 ? tap_first<1>(hl1, x) : tap_prev<1>(xp, x), p2 = m == 0 ? tap_first<2>(hl2, x) : tap_prev<2>(xp, x), p3 = m == 0 ? tap_first<3>(hl3, x) : tap_prev<3>(xp, x);
                        const f32x4 o = bb + w0 * p3 + w1 * p2 + w2 * p1 + w3 * x;
                        const bool skip = !seq_first && grp == 0 && m == 0 && fr < 3;
                        if (!skip) *(h4*)(xc + (size_t)(rowb + ai * 128 + m * 16) * D + ch) = cvt_h4(o);
                    }
                }
            }
            asm volatile("" ::: "memory");
        }
    }
};
struct MiniInConv {
    static constexpr bool RINV = true, IDEM = true;
    const float* ss; const float* cw; const float* cb; const float* st; f16* gg; f16* xc; float* sconv;
    __device__ __forceinline__ int nunits() const { return 16 * 32; }
    __device__ __forceinline__ int acol(int) const { return 0; }
    __device__ __forceinline__ int brow(int x, int c) const { return 64 * x + 16 * c; }
    __device__ __forceinline__ void tile(int rb, int x, LAS float* T, int tid) const {
        const int rowl = tid >> 4, cq = (tid & 15) * 4, srow = 32 * rb + rowl, b = srow >> 2, t = srow & 3;
        const f32x4 v = *(const LAS f32x4*)(T + rowl * 64 + cq);
        if (x < 16) { f32x4 g; g.x = gelu_tanh(v.x); g.y = gelu_tanh(v.y); g.z = gelu_tanh(v.z); g.w = gelu_tanh(v.w); *(h4*)(gg + (size_t)(MP + srow) * D + 64 * x + cq) = cvt_h4(g); return; }
        const int ch = 64 * (x - 16) + cq;
        f32x4 o = *(const f32x4*)(cb + ch);
#pragma unroll
        for (int j = 0; j < 4; ++j) { const int tt = t - 3 + j; const f32x4 xv = tt >= 0 ? *(const LAS f32x4*)(T + (rowl - 3 + j) * 64 + cq) : *(const f32x4*)(st + ((size_t)b * 3 + (t + j)) * D + ch); o += *(const f32x4*)(cw + j * D + ch) * xv; }
        *(h4*)(xc + (size_t)(MP + srow) * D + ch) = cvt_h4(o);
        if (t >= 1) *(f32x4*)(sconv + ((size_t)b * 3 + (t - 1)) * D + ch) = v;
    }
};
__device__ __forceinline__ void g2_fixup(Ctx& C, int l, int pm, int blk) {
    const int tid_o = opq_tid();
    if ((pm & 15) != 0) {
        const float* sf = WSP(float, WS_SIDEAF) + (size_t)pm * 3 * D; const float* sl = WSP(float, WS_SIDEAL) + (size_t)(pm - 1) * 3 * D;
        const float* cw = INP(9) + (size_t)l * 4 * D; const float* cb = INP(10) + (size_t)l * D; f16* xc = WSP(f16, WS_XC) + (size_t)pm * 256 * D;
        for (int i = tid_o; i < 3 * 256; i += 512) {
            const int j = i >> 8, ch = blk * 256 + (i & 255);
            float o = cb[ch];
#pragma unroll
            for (int k = 0; k < 4; ++k) { const int rr = j - 3 + k; const float xv = rr >= 0 ? sf[(size_t)rr * D + ch] : sl[(size_t)(3 + rr) * D + ch]; o += cw[k * D + ch] * xv; }
            xc[(size_t)j * D + ch] = (f16)o;
        }
    }
}

__device__ __forceinline__ void g5_fixup(Ctx& C, int L, int pm) {
    const int tid_o = opq_tid();
    if ((pm & 15) != 0) {
        const float* sidef = WSP(float, WS_SIDEF) + (size_t)pm * 2 * (2 * DFF); const float* sidel = WSP(float, WS_SIDEL) + (size_t)(pm - 1) * 2 * DFF;
        const float* cw = INP(26) + (size_t)L * 3 * DFF; const float* cb = INP(27) + (size_t)L * DFF; f16* mid = WSP(f16, WS_MID) + (size_t)pm * 256 * DFF;
        for (int i = tid_o; i < 2 * DFF; i += 512) {
            const int j = i / DFF, ch = i - j * DFF;
            const float g0 = sidef[(size_t)j * 2 * DFF + ch], v = sidef[(size_t)j * 2 * DFF + DFF + ch];
            const float p1 = j == 0 ? sidel[DFF + ch] : sidef[ch], p2 = j == 0 ? sidel[ch] : sidel[DFF + ch];
            const float gc = cb[ch] + cw[ch] * p2 + cw[DFF + ch] * p1 + cw[2 * DFF + ch] * g0;
            mid[(size_t)j * DFF + ch] = (f16)(gelu_tanh(gc) * v);
        }
    }
    VM_WAIT(); __syncthreads();
}

__constant__ float ROPE_INV[8] = {1.0f, 0.19392274474868576f, 0.03760603093086393f, 0.007292664737217109f, 0.001414213562373095f, 0.0002742481756762073f, 5.318295896944988e-05f, 1.031338537721246e-05f};
__device__ __forceinline__ unsigned pk2h(float lo, float hi) { const h2 a = __builtin_convertvector((f32x2){lo, hi}, h2); return __builtin_bit_cast(unsigned, a); }
__device__ __forceinline__ int perm_row(int perm, int n) { if (perm == 3) { const int hd = n >> 6, dim = n & 63; return 256 * (hd >> 2) + 128 * (dim >> 5) + 32 * (hd & 3) + (dim & 31); }
    if (perm == 2) return 256 * (n >> 7) + (n & 127);
    if (perm == 1) { const int c = n < DFF ? n : n - DFF; return 256 * (c >> 7) + (c & 127) + (n < DFF ? 0 : 128); } return n; }
struct TrDesc { const float* W; f16* WT; const float* gain; int N, ldt, row_off, item, perm; };
__device__ __forceinline__ void tr_load(const TrDesc& d, int lane, f32x4 (&v)[8]) {
    const int nblk = d.N / 32, kb = d.item / nblk, nb = d.item % nblk, k0 = 64 * kb, n0 = 32 * nb;
    const GAS float* p = (const GAS float*)d.W + (size_t)(k0 + (lane >> 3)) * d.N + n0 + 4 * (lane & 7);
#pragma unroll
    for (int i = 0; i < 8; ++i) v[i] = __builtin_nontemporal_load((const GAS f32x4*)(p + (size_t)(8 * i) * d.N));
}
__device__ __forceinline__ void tr_finish(const TrDesc& d, int lane, const f32x4 (&v)[8], LAS float* scr) {
    const int nblk = d.N / 32, kb = d.item / nblk, nb = d.item % nblk, k0 = 64 * kb, n0 = 32 * nb, r0 = perm_row(d.perm, n0);
#pragma unroll
    for (int i = 0; i < 8; ++i) { LAS float* q = scr + ((lane >> 3) + 8 * i) * 33 + 4 * (lane & 7); q[0] = v[i].x; q[1] = v[i].y; q[2] = v[i].z; q[3] = v[i].w; }
    const int c = lane & 7;
    f32x4 g0 = (f32x4){1.f, 1.f, 1.f, 1.f}, g1 = g0;
    if (d.gain) { g0 = *(const f32x4*)(d.gain + k0 + 8 * c); g1 = *(const f32x4*)(d.gain + k0 + 8 * c + 4); }
    LDS_WAIT(); asm volatile("" ::: "memory");
#pragma unroll
    for (int j = 0; j < 4; ++j) { const int n = (lane >> 3) + 8 * j; const LAS float* s = scr + (8 * c) * 33 + n;
        u32x4 o; o.x = pk2h(s[0 * 33] * g0.x, s[1 * 33] * g0.y); o.y = pk2h(s[2 * 33] * g0.z, s[3 * 33] * g0.w); o.z = pk2h(s[4 * 33] * g1.x, s[5 * 33] * g1.y); o.w = pk2h(s[6 * 33] * g1.z, s[7 * 33] * g1.w);
        *(u32x4*)(d.WT + (size_t)(d.row_off + r0 + n) * d.ldt + k0 + 8 * c) = o; }
    LDS_WAIT(); asm volatile("" ::: "memory");
}
constexpr int P0_NITEMS = 2048 + 512 + 1024 + 512 + 768 + 768 + 512 + 12288 + 6144;
__device__ __forceinline__ TrDesc tr_lookup(Ctx& C, int it) {
    int r = it;
    if (r < 2048) { const int l = r >> 10; return TrDesc{INP(8) + (size_t)l * D * 2048, WSP(f16, WS_WIN) + (size_t)l * 2048 * D, INP(7) + l * D, 2048, D, 0, r & 1023, 0}; } r -= 2048;
    if (r < 512) { const int l = r >> 8, rr = r & 255, blk = rr >> 6, ri = (rr >> 5) & 1, item = rr & 31;
        return TrDesc{(ri ? INP(13) : INP(11)) + ((size_t)l * 4 + blk) * 65536, WSP(f16, WS_WG) + (size_t)l * 2048 * 256, nullptr, 256, 256, blk * 512 + ri * 128, item, 2}; } r -= 512;
    if (r < 1024) { const int l = r >> 9; return TrDesc{INP(16) + (size_t)l * D * D, WSP(f16, WS_WOUT) + (size_t)l * D * D, nullptr, D, D, 0, r & 511, 0}; } r -= 1024;
    if (r < 512) return TrDesc{INP(18), WSP(f16, WS_WKVQ), INP(17), 1024, D, 0, r, 3}; r -= 512;
    if (r < 768) return TrDesc{INP(21), WSP(f16, WS_WKVQ), INP(20), 1536, D, 1024, r, 3}; r -= 768;
    if (r < 768) return TrDesc{INP(21) + (size_t)D * 1536, WSP(f16, WS_WQ1), INP(20) + D, 1536, D, 0, r, 3}; r -= 768;
    if (r < 512) { const int j = r >> 8; return TrDesc{INP(23) + (size_t)j * 512 * D, WSP(f16, WS_WO) + (size_t)j * D * 512, nullptr, D, 512, 0, r & 255, 0}; } r -= 512;
    if (r < 12288) { const int l = r / 3072; return TrDesc{INP(25) + (size_t)l * D * 6144, WSP(f16, WS_WUP) + (size_t)l * 6144 * D, INP(24) + l * D, 6144, D, 0, r % 3072, 1}; } r -= 12288;
    { const int l = r / 1536; return TrDesc{INP(28) + (size_t)l * DFF * D, WSP(f16, WS_WDN) + (size_t)l * D * DFF, nullptr, D, DFF, 0, r % 1536, 0}; }
}
constexpr int CV_A = 4864 + 6144 + 3072, CV_B = 768 + 512 + 3072 + 1536, CV_C = 3072 + 1536;
__device__ __forceinline__ int cv_map(int grp, int j) {
    if (grp == 0) { if (j < 4864) return j; j -= 4864; if (j < 6144) return 6144 + j; return 18432 + (j - 6144); }
    if (grp == 1) { if (j < 1280) return 4864 + j; j -= 1280; if (j < 3072) return 6144 + 6144 + j; return 18432 + 3072 + (j - 3072); }
    if (j < 3072) return 6144 + 9216 + j; return 18432 + 4608 + (j - 3072);
}
__device__ __forceinline__ void convert_weights(Ctx& C, int grp, int nitems, int rank, int nwg) {
    const int tid_o = opq_tid(), lane = tid_o & 63, wave_o = __builtin_amdgcn_readfirstlane(tid_o >> 6);
    LAS float* scr = (LAS float*)(C.lds + wave_o * 16384);
    const int gw = rank * NWAVES + wave_o, NGW = nwg * NWAVES;
    int it = gw; bool have = it < nitems; TrDesc d0{}; f32x4 v0[8];
    if (have) { d0 = tr_lookup(C, cv_map(grp, it)); tr_load(d0, lane, v0); }
    while (have) {
        const int itn = it + NGW; const bool haven = itn < nitems; TrDesc d1{}; f32x4 v1[8];
        if (haven) { d1 = tr_lookup(C, cv_map(grp, itn)); tr_load(d1, lane, v1); }
        tr_finish(d0, lane, v0, scr);
        if (haven) { d0 = d1;
#pragma unroll
            for (int i = 0; i < 8; ++i) v0[i] = v1[i]; }
        it = itn; have = haven;
    }
}
__device__ __forceinline__ void p0_prologue(Ctx& C) {
    const int tid_o = opq_tid(), lane_o = tid_o & 63, wave_o = __builtin_amdgcn_readfirstlane(tid_o >> 6); (void)lane_o; (void)wave_o;
    LAS float* scr = (LAS float*)(C.lds + wave_o * 16384);
    const int gw = C.bid * NWAVES + wave_o, NGW = C.G * NWAVES, lane = lane_o;
    convert_weights(C, 0, CV_A, C.bid, C.G);
    for (int i = C.bid * 512 + tid_o; i < 2 * D; i += C.G * 512) WSP(float, WS_SPL)[i] = -8.0f * log1pf(expf(-INP(15)[i]));
    for (int i = C.bid * 512 + tid_o; i < 4100 * 8; i += C.G * 512) { const int p = i >> 3, k = i & 7; const float pos = (float)(p < SEQ ? p : NPAST + (p - SEQ)), ang = pos * ROPE_INV[k];
        WSP(float, WS_ROPE)[p * 16 + k] = cosf(ang); WSP(float, WS_ROPE)[p * 16 + 8 + k] = sinf(ang); }
    f16* xh = WSP(f16, WS_XH); float* ss = WSP(float, WS_SS);
    for (int m0 = gw; m0 < M; m0 += 2 * NGW) {
        f32x4 v[2][4]; const int m1 = m0 + NGW; const bool two = m1 < M;
#pragma unroll
        for (int q = 0; q < 2; ++q) { const int m = q == 0 ? m0 : (two ? m1 : m0); const float* xrow = m < MP ? INP(0) + (size_t)m * D : INP(1) + (size_t)(m - MP) * D;
#pragma unroll
            for (int j = 0; j < 4; ++j) v[q][j] = __builtin_nontemporal_load((const f32x4*)(xrow + 4 * lane + 256 * j)); }
#pragma unroll
        for (int q = 0; q < 2; ++q) { const int m = q == 0 ? m0 : m1; if (q == 1 && !two) break;
            float s2 = 0.f;
#pragma unroll
            for (int j = 0; j < 4; ++j) { const f32x4 w = v[q][j]; s2 += (w.x * w.x + w.y * w.y) + (w.z * w.z + w.w * w.w); *(h4*)(xh + (size_t)m * D + 4 * lane + 256 * j) = cvt_h4(w); }
            s2 = wave_sum(s2);
            if (lane < 16) ss[(size_t)m * 16 + lane] = lane == 0 ? s2 : 0.f; }
    }
}

__device__ __forceinline__ void e1_conv_a(Ctx& C, int l) {
    const int tid_o = opq_tid(), lane_o = tid_o & 63, wave_o = __builtin_amdgcn_readfirstlane(tid_o >> 6); (void)lane_o; (void)wave_o;
    const f16* xb = WSP(f16, WS_XB); f16* xc = WSP(f16, WS_XC);
    const float* cw = INP(9) + (size_t)l * 4 * D; const float* cb = INP(10) + (size_t)l * D; const float* st = INP(5) + (size_t)l * BS * 3 * D;
    const size_t total = (size_t)M * (D / 8), stride = (size_t)C.G * 512;
    for (size_t it = (size_t)C.bid * 512 + tid_o; it < total; it += stride) {
        const int row = (int)(it >> 7), c = (int)(it & 127) * 8;
        bool smp; int b, t; row_bt(row, smp, b, t);
        float acc[8];
#pragma unroll
        for (int e = 0; e < 8; ++e) acc[e] = cb[c + e];
#pragma unroll
        for (int j = 0; j < 4; ++j) {
            const int tt = t - 3 + j; float xv[8];
            if (tt >= 0) { const h8 v = *(const h8*)(xb + (size_t)(row - 3 + j) * D + c);
#pragma unroll
                for (int e = 0; e < 8; ++e) xv[e] = (float)v[e]; }
            else if (smp) { const float* p = st + ((size_t)b * 3 + (t + j)) * D + c;
#pragma unroll
                for (int e = 0; e < 8; ++e) xv[e] = p[e]; }
            else {
#pragma unroll
                for (int e = 0; e < 8; ++e) xv[e] = 0.f; }
#pragma unroll
            for (int e = 0; e < 8; ++e) acc[e] += cw[j * D + c + e] * xv[e];
        }
        h8 o;
#pragma unroll
        for (int e = 0; e < 8; ++e) o[e] = (f16)acc[e];
        *(h8*)(xc + (size_t)row * D + c) = o;
    }
}
__device__ __forceinline__ void e2a_scan_carry(Ctx& C) {
    const int tid_o = opq_tid(), lane_o = tid_o & 63, wave_o = __builtin_amdgcn_readfirstlane(tid_o >> 6); (void)lane_o; (void)wave_o;
    const float* la = WSP(float, WS_LA); const float* ix = WSP(float, WS_IX); float* ca = WSP(float, WS_CA); float* chh = WSP(float, WS_CH);
    const int total = BP * 32 * D;
    for (int it = C.bid * 512 + tid_o; it < total; it += C.G * 512) {
        const int c = it & (D - 1), k = (it >> 10) & 31, b = it >> 15;
        const size_t base = ((size_t)b * SEQ + k * 128) * D + c;
        float Ap = 1.f, H = 0.f;
#pragma unroll 8
        for (int t = 0; t < 128; ++t) { const float l2 = la[base + (size_t)t * D], xi = ix[base + (size_t)t * D];
            const float a = __expf(l2), u = sqrtf(-expm1f(2.0f * l2)) * xi; Ap *= a; H = a * H + u; }
        ca[it] = Ap; chh[it] = H;
    }
}
__device__ __forceinline__ void e2b_scan_apply(Ctx& C, int l) {
    const int tid_o = opq_tid(), lane_o = tid_o & 63, wave_o = __builtin_amdgcn_readfirstlane(tid_o >> 6); (void)lane_o; (void)wave_o;
    const float* la = WSP(float, WS_LA); const float* ix = WSP(float, WS_IX); const float* ca = WSP(float, WS_CA); const float* chh = WSP(float, WS_CH);
    const f16* gg = WSP(f16, WS_GG); f16* y = WSP(f16, WS_Y);
    const int totalp = BP * 32 * D, totals = BS * D;
    for (int it = C.bid * 512 + tid_o; it < totalp + totals; it += C.G * 512) {
        if (it < totalp) {
            const int c = it & (D - 1), k = (it >> 10) & 31, b = it >> 15;
            float h = 0.f;
            for (int j = 0; j < k; ++j) { const int ci = ((b * 32 + j) << 10) + c; h = ca[ci] * h + chh[ci]; }
            const size_t base = ((size_t)b * SEQ + k * 128) * D + c;
#pragma unroll 8
            for (int t = 0; t < 128; ++t) { const size_t o = base + (size_t)t * D; const float l2 = la[o], xi = ix[o];
                const float a = __expf(l2), u = sqrtf(-expm1f(2.0f * l2)) * xi; h = a * h + u; y[o] = (f16)(h * (float)gg[o]); }
            if (k == 31) OUTP[O_PH + ((size_t)l * BP + b) * D + c] = h;
        } else {
            const int i2 = it - totalp, c = i2 & (D - 1), b = i2 >> 10;
            float h = INP(4)[((size_t)l * BS + b) * D + c];
            const size_t base = ((size_t)MP + b * 4) * D + c;
#pragma unroll
            for (int t = 0; t < 4; ++t) { const size_t o = base + (size_t)t * D; const float l2 = la[o], xi = ix[o];
                const float a = __expf(l2), u = sqrtf(-expm1f(2.0f * l2)) * xi; h = a * h + u; y[o] = (f16)(h * (float)gg[o]); }
            OUTP[O_SH + ((size_t)l * BS + b) * D + c] = h;
        }
    }
}
__device__ __forceinline__ void e3_geglu(Ctx& C, int L) {
    const int tid_o = opq_tid(), lane_o = tid_o & 63, wave_o = __builtin_amdgcn_readfirstlane(tid_o >> 6); (void)lane_o; (void)wave_o;
    const f16* g = WSP(f16, WS_G); const f16* v = WSP(f16, WS_V); f16* mid = WSP(f16, WS_MID);
    const float* cw = INP(26) + (size_t)L * 3 * DFF; const float* cb = INP(27) + (size_t)L * DFF; const float* st = INP(6) + (size_t)L * BS * 2 * DFF;
    const size_t total = (size_t)M * (DFF / 8), stride = (size_t)C.G * 512;
    for (size_t it = (size_t)C.bid * 512 + tid_o; it < total; it += stride) {
        const int row = (int)(it / 384), c = (int)(it % 384) * 8;
        bool smp; int b, t; row_bt(row, smp, b, t);
        float acc[8];
#pragma unroll
        for (int e = 0; e < 8; ++e) acc[e] = cb[c + e];
#pragma unroll
        for (int j = 0; j < 3; ++j) {
            const int tt = t - 2 + j; float xv[8];
            if (tt >= 0) { const h8 q = *(const h8*)(g + (size_t)(row - 2 + j) * DFF + c);
#pragma unroll
                for (int e = 0; e < 8; ++e) xv[e] = (float)q[e]; }
            else if (smp) { const float* p = st + ((size_t)b * 2 + (t + j)) * DFF + c;
#pragma unroll
                for (int e = 0; e < 8; ++e) xv[e] = p[e]; }
            else {
#pragma unroll
                for (int e = 0; e < 8; ++e) xv[e] = 0.f; }
#pragma unroll
            for (int e = 0; e < 8; ++e) acc[e] += cw[j * DFF + c + e] * xv[e];
        }
        const h8 vv = *(const h8*)(v + (size_t)row * DFF + c);
        h8 o;
#pragma unroll
        for (int e = 0; e < 8; ++e) o[e] = (f16)(gelu_tanh(acc[e]) * (float)vv[e]);
        *(h8*)(mid + (size_t)row * DFF + c) = o;
    }
}
__device__ __forceinline__ void e4_headnorm_rope(Ctx& C, int mode) {
    const int tid_o = opq_tid(), lane_o = tid_o & 63, wave_o = __builtin_amdgcn_readfirstlane(tid_o >> 6); (void)lane_o; (void)wave_o;
    const float* raw = WSP(float, WS_RAW); f16* kh = WSP(f16, WS_KH); f16* vh = WSP(f16, WS_VH); f16* qh = WSP(f16, WS_QH);
    const int nslot = mode == 0 ? 40 : 24, ld = mode == 0 ? 2560 : 1536, qbase = mode == 0 ? 16 : 0, jq = mode == 0 ? 0 : 1;
    const float* kg = INP(19); const float* qg = INP(22) + jq * HD;
    const size_t total = (size_t)M * nslot, stride = (size_t)C.G * 32;
    const int sub = lane_o & 15, grp = tid_o >> 4;
    for (size_t it = (size_t)C.bid * 32 + grp; it < total; it += stride) {
        const int row = (int)(it / nslot), slot = (int)(it % nslot);
        bool smp; int b, t; row_bt(row, smp, b, t);
        f32x4 v = *(const f32x4*)(raw + (size_t)row * ld + slot * 64 + sub * 4);
        const bool isv = (mode == 0) && slot >= 8 && slot < 16;
        const bool isk = (mode == 0) && slot < 8;
        float s = (v.x * v.x + v.y * v.y) + (v.z * v.z + v.w * v.w);
        s += __shfl_xor(s, 1); s += __shfl_xor(s, 2); s += __shfl_xor(s, 4); s += __shfl_xor(s, 8);
        f32x4 o = v;
        if (!isv) {
            const float rn = __builtin_amdgcn_rsqf(s * (1.0f / HD) + EPS);
            const f32x4 gv = *(const f32x4*)((isk ? kg : qg) + sub * 4);
            o = v * rn * gv;
        }
        f32x4 p; p.x = __shfl_xor(o.x, 2); p.y = __shfl_xor(o.y, 2); p.z = __shfl_xor(o.z, 2); p.w = __shfl_xor(o.w, 2);
        if (!isv && sub < 4) {
            const float pos = (float)(smp ? NPAST + t : t);
            const int i0 = (sub & 1) * 4;
            float cs[4], sn[4];
#pragma unroll
            for (int e = 0; e < 4; ++e) { const float ang = pos * ROPE_INV[i0 + e]; cs[e] = cosf(ang); sn[e] = sinf(ang); }
            if (sub < 2) { o.x = o.x * cs[0] - p.x * sn[0]; o.y = o.y * cs[1] - p.y * sn[1]; o.z = o.z * cs[2] - p.z * sn[2]; o.w = o.w * cs[3] - p.w * sn[3]; }
            else { o.x = o.x * cs[0] + p.x * sn[0]; o.y = o.y * cs[1] + p.y * sn[1]; o.z = o.z * cs[2] + p.z * sn[2]; o.w = o.w * cs[3] + p.w * sn[3]; }
        }
        if (isk || isv) {
            const int h = slot & 7; f16* dst = isk ? kh : vh;
            *(h4*)(dst + (size_t)row * DKV + h * 64 + sub * 4) = cvt_h4(o);
            unsigned co = 0u;
            if (!smp) { if (t >= SEQ - 2048) co = (unsigned)(isk ? O_PCK : O_PCV) + (unsigned)(((b * 2048 + (t - (SEQ - 2048))) * NH + h) * HD + sub * 4); }
            else co = (unsigned)(isk ? O_SCK : O_SCV) + (unsigned)(((b * 4 + t) * NH + h) * HD + sub * 4);
            if (co) *(f32x4*)(OUTP + co) = o;
        } else {
            const int qs = slot - qbase;
            *(h4*)(qh + (size_t)row * 1536 + qs * 64 + sub * 4) = cvt_h4(o * 0.125f);
        }
    }
}
__device__ __forceinline__ void e5_merge(Ctx& C) {
    const int tid_o = opq_tid(), lane_o = tid_o & 63, wave_o = __builtin_amdgcn_readfirstlane(tid_o >> 6); (void)lane_o; (void)wave_o;
    const f16* og = WSP(f16, WS_OG); const float* lse = WSP(float, WS_LSE); f16* att = WSP(f16, WS_ATT);
    const size_t total = (size_t)M * NH * 8, stride = (size_t)C.G * 512;
    for (size_t it = (size_t)C.bid * 512 + tid_o; it < total; it += stride) {
        const int sub = (int)(it & 7), h = (int)((it >> 3) & 7), row = (int)(it >> 6);
        const float l0 = lse[((size_t)0 * M + row) * NH + h], l1 = lse[((size_t)1 * M + row) * NH + h], l2 = lse[((size_t)2 * M + row) * NH + h];
        const float mx = fmaxf(l0, fmaxf(l1, l2));
        float w0 = __expf(l0 - mx), w1 = __expf(l1 - mx), w2 = __expf(l2 - mx); const float inv = 1.0f / (w0 + w1 + w2); w0 *= inv; w1 *= inv; w2 *= inv;
        const size_t o = (size_t)row * DKV + h * 64 + sub * 8;
        const h8 a = *(const h8*)(og + o), b2 = *(const h8*)(og + (size_t)M * DKV + o), c2 = *(const h8*)(og + (size_t)2 * M * DKV + o);
        h8 r;
#pragma unroll
        for (int e = 0; e < 8; ++e) r[e] = (f16)(w0 * (float)a[e] + w1 * (float)b2[e] + w2 * (float)c2[e]);
        *(h8*)(att + o) = r;
    }
}

constexpr int KV_STRIDE = 144;
constexpr int KV_ROWS = 400;
constexpr int ATT_K_OFF = 0, ATT_V_OFF = KV_ROWS * KV_STRIDE;
__device__ __forceinline__ s16x4 tr_read(LAS unsigned char* p) { return __builtin_amdgcn_ds_read_tr16_b64_v4i16((LAS s16x4*)p); }
__device__ __forceinline__ void att_prompt(Ctx& C, const int prank, const int pcnt, const int uend) {
    const int tid_o = opq_tid(), lane_o = tid_o & 63, wave_o = __builtin_amdgcn_readfirstlane(tid_o >> 6); (void)lane_o; (void)wave_o;
    const f16* qh = WSP(f16, WS_QH); const f16* kh = WSP(f16, WS_KH); const f16* vh = WSP(f16, WS_VH); f16* og = WSP(f16, WS_OG); float* lse = WSP(float, WS_LSE);
    LAS unsigned char* Ks = C.lds + ATT_K_OFF; LAS unsigned char* Vs = C.lds + ATT_V_OFF;
    const int tid = tid_o, lane = lane_o, w = wave_o, l15 = lane & 15, lq = lane >> 4;
    for (int i = tid; i < 16 * KV_STRIDE / 4; i += 512) { ((LAS unsigned*)(Vs + 384 * KV_STRIDE))[i] = 0u; ((LAS unsigned*)(Ks + 384 * KV_STRIDE))[i] = 0u; }
    __syncthreads();
    constexpr int NUNITS = BP * NH * 48;
#define AU_DECODE(xx, bhh, b_, h_, g_, d_, r_, n_) const int h_ = (bhh) & 7, b_ = (bhh) >> 3, g_ = (xx) >> 4, d_ = 1 << (2 * g_), \
        r_ = g_ == 0 ? 0 : (g_ == 1 ? ((xx) - 16) >> 2 : (xx) - 32), n_ = g_ == 0 ? (xx) : (g_ == 1 ? ((xx) - 16) & 3 : 0);
#define AU_FETCH(rs, b_, h_, d_, r_, n_, dst) do { _Pragma("unroll") for (int i_ = 0; i_ < 6; ++i_) { const int ch_ = tid + 512 * i_, kk_ = ch_ >> 3, c8_ = ch_ & 7, mk_ = 256 * (n_) - 128 + kk_; \
            const unsigned vo_ = mk_ >= 0 ? (unsigned)(((b_) * SEQ + (d_) * mk_ + (r_)) * DKV + (h_) * 64 + c8_ * 8) * 2u : 0xFFFFFFF0u; \
            dst[i_] = __builtin_amdgcn_raw_buffer_load_b128(rs, (int)vo_, 0, 0); } } while (0)
#define AU_TO_LDS(base, src) do { _Pragma("unroll") for (int i_ = 0; i_ < 6; ++i_) { const int ch_ = tid + 512 * i_, kk_ = ch_ >> 3, c8_ = ch_ & 7; *(LAS u32x4*)((base) + kk_ * KV_STRIDE + c8_ * 16) = src[i_]; } } while (0)
    const __amdgpu_buffer_rsrc_t krs = __builtin_amdgcn_make_buffer_rsrc((void*)kh, 0, M * DKV * 2, 0x00020000), vrs = __builtin_amdgcn_make_buffer_rsrc((void*)vh, 0, M * DKV * 2, 0x00020000);
    u32x4 stg[6];
    const int vb0 = prank;
    int ux = vb0 % 48, ubh = vb0 / 48; const int sx = pcnt % 48, sbh = pcnt / 48;
    if (vb0 < uend) { AU_DECODE(ux, ubh, pb_, ph_, pg_, pd_, pr_, pn_) (void)pg_; AU_FETCH(krs, pb_, ph_, pd_, pr_, pn_, stg); }
    for (int u = vb0; u < uend; u += pcnt) {
        AU_DECODE(ux, ubh, b, h, g, d, r, n)
        AU_TO_LDS(Ks, stg);
        AU_FETCH(vrs, b, h, d, r, n, stg);
        h8 qf[2][2];
#pragma unroll
        for (int qb = 0; qb < 2; ++qb) { const size_t qrow_ = (size_t)b * SEQ + (size_t)d * (256 * n + 128 * qb + 16 * w + l15) + r;
            qf[qb][0] = *(const GAS h8*)((const GAS f16*)qh + qrow_ * 1536 + g * 512 + h * 64 + 8 * lq); qf[qb][1] = *(const GAS h8*)((const GAS f16*)qh + qrow_ * 1536 + g * 512 + h * 64 + 32 + 8 * lq); }
        __syncthreads();
        h8 pf[2][5]; float mxs[2], dens[2];
#pragma unroll
        for (int qb = 0; qb < 2; ++qb) {
            const int kb0 = 128 * qb + 16 * w, qi = kb0 + l15;
            f32x4 s[10];
#pragma unroll
            for (int bb = 0; bb < 10; ++bb) {
                const LAS unsigned char* kp = Ks + (kb0 + 16 * bb + l15) * KV_STRIDE + 16 * lq;
                const h8 k0 = *(const LAS h8*)kp, k1 = *(const LAS h8*)(kp + 64);
                f32x4 a = (f32x4){0.f, 0.f, 0.f, 0.f};
                a = __builtin_amdgcn_mfma_f32_16x16x32_f16(k0, qf[qb][0], a, 0, 0, 0);
                a = __builtin_amdgcn_mfma_f32_16x16x32_f16(k1, qf[qb][1], a, 0, 0, 0);
                s[bb] = a;
            }
            const int lo = max(0, (n == 0 ? 128 : 0) - qi), dl = 4 * lq - l15 - lo; const unsigned span = (unsigned)(128 - lo);
            float mx = -INFINITY;
#pragma unroll
            for (int bb = 0; bb < 10; ++bb)
#pragma unroll
                for (int e = 0; e < 4; ++e) { const bool ok = (unsigned)(16 * bb + e + dl) <= span;
                    s[bb][e] = ok ? s[bb][e] : -INFINITY; mx = fmaxf(mx, s[bb][e]); }
            mx = fmaxf(mx, __shfl_xor(mx, 16)); mx = fmaxf(mx, __shfl_xor(mx, 32));
            float den = 0.f;
#pragma unroll
            for (int bb = 0; bb < 10; ++bb)
#pragma unroll
                for (int e = 0; e < 4; ++e) { const float p = __expf(s[bb][e] - mx); s[bb][e] = p; den += p; }
            den += __shfl_xor(den, 16); den += __shfl_xor(den, 32);
            mxs[qb] = mx; dens[qb] = den;
#pragma unroll
            for (int c = 0; c < 5; ++c) { const h4 plo = cvt_h4(s[2 * c]), phi = cvt_h4(s[2 * c + 1]); pf[qb][c] = (h8){plo.x, plo.y, plo.z, plo.w, phi.x, phi.y, phi.z, phi.w}; }
        }
        AU_TO_LDS(Vs, stg);
        ux += sx; ubh += sbh; if (ux >= 48) { ux -= 48; ++ubh; }
        if (u + pcnt < uend) { AU_DECODE(ux, ubh, nb_, nh_, ng_, nd_, nr_, nn_) (void)ng_; AU_FETCH(krs, nb_, nh_, nd_, nr_, nn_, stg); }
        __syncthreads();
#pragma unroll
        for (int qb = 0; qb < 2; ++qb) {
            const int kb0 = 128 * qb + 16 * w;
            const size_t qrow = (size_t)b * SEQ + (size_t)d * (256 * n + kb0 + l15) + r;
            f32x4 o[4];
#pragma unroll
            for (int db = 0; db < 4; ++db) o[db] = (f32x4){0.f, 0.f, 0.f, 0.f};
#pragma unroll
            for (int c = 0; c < 5; ++c) {
                const int r0 = kb0 + 32 * c + 4 * lq + (l15 >> 2);
#pragma unroll
                for (int db = 0; db < 4; ++db) {
                    const s16x4 lo = tr_read(Vs + r0 * KV_STRIDE + (16 * db + 4 * (l15 & 3)) * 2), hi = tr_read(Vs + (r0 + 16) * KV_STRIDE + (16 * db + 4 * (l15 & 3)) * 2);
                    const h4 vlo = __builtin_bit_cast(h4, lo), vhi = __builtin_bit_cast(h4, hi);
                    const h8 va = (h8){vlo.x, vlo.y, vlo.z, vlo.w, vhi.x, vhi.y, vhi.z, vhi.w};
                    o[db] = __builtin_amdgcn_mfma_f32_16x16x32_f16(va, pf[qb][c], o[db], 0, 0, 0);
                }
            }
            const float inv = 1.0f / dens[qb];
            f16* orow = og + ((size_t)g * M + qrow) * DKV + h * 64;
#pragma unroll
            for (int db = 0; db < 4; ++db) *(h4*)(orow + 16 * db + 4 * lq) = cvt_h4(o[db] * inv);
            if (lq == 0) lse[((size_t)g * M + qrow) * NH + h] = mxs[qb] + __logf(dens[qb]);
        }
    }
    __syncthreads();
}
#undef AU_DECODE
#undef AU_FETCH
#undef AU_TO_LDS
__device__ __forceinline__ float dpp_q1(float v) { return __builtin_bit_cast(float, __builtin_amdgcn_update_dpp(0, __builtin_bit_cast(int, v), 0xB1, 0xf, 0xf, false)); }
__device__ __forceinline__ float dpp_q2(float v) { return __builtin_bit_cast(float, __builtin_amdgcn_update_dpp(0, __builtin_bit_cast(int, v), 0x4E, 0xf, 0xf, false)); }
__device__ __forceinline__ float dpp_hm(float v) { return __builtin_bit_cast(float, __builtin_amdgcn_update_dpp(0, __builtin_bit_cast(int, v), 0x141, 0xf, 0xf, false)); }
__device__ __forceinline__ float sum8(float v) { v += dpp_q1(v); v += dpp_q2(v); v += dpp_hm(v); return v; }
__device__ __forceinline__ float max8(float v) { v = fmaxf(v, dpp_q1(v)); v = fmaxf(v, dpp_q2(v)); v = fmaxf(v, dpp_hm(v)); return v; }
__device__ __forceinline__ void att_sample(Ctx& C) {
    const int tid_o = opq_tid(), lane_o = tid_o & 63, wave_o = __builtin_amdgcn_readfirstlane(tid_o >> 6);
    const f16* qh = WSP(f16, WS_QH); const f16* kh = WSP(f16, WS_KH); const f16* vh = WSP(f16, WS_VH); f16* og = WSP(f16, WS_OG); float* lse = WSP(float, WS_LSE);
    const GAS float* ck = (const GAS float*)INP(2); const GAS float* cv = (const GAS float*)INP(3);
    const int lane = lane_o, hh = lane >> 3, sub = lane & 7;
    const int gw = C.bid * NWAVES + wave_o, NGW = C.G * NWAVES;
    for (int us = gw; us < BS * 16; us += NGW) {
        const int sl = us & 15; if (sl >= 12) continue;
        const int s = sl & 3, g = sl >> 2, b = us >> 4, d = g == 0 ? 1 : (g == 1 ? 4 : 16);
        const size_t qrow = (size_t)MP + b * 4 + s;
        float q[8];
        { const h8 qv = *(const h8*)(qh + qrow * 1536 + g * 512 + hh * 64 + sub * 8);
#pragma unroll
          for (int e = 0; e < 8; ++e) q[e] = (float)qv[e]; }
        const int nn = g == 0 ? s + 1 : 1;
        float scn[4];
#pragma unroll
        for (int j = 0; j < 4; ++j) {
            scn[j] = -INFINITY;
            if (j < nn) { const size_t ro = ((size_t)MP + b * 4 + (s - j)) * DKV + lane * 8; const h8 k8 = *(const h8*)(kh + ro);
                float a = 0.f;
#pragma unroll
                for (int e = 0; e < 8; ++e) a += q[e] * (float)k8[e];
                scn[j] = sum8(a); }
        }
        const int i0 = g == 0 ? NPAST - 1 : NPAST + s - d, nvalid = g == 0 ? 128 - s : 128;
        const __amdgpu_buffer_rsrc_t kbase = __builtin_amdgcn_make_buffer_rsrc((void*)(ck + (size_t)b * NPAST * DKV), 0, NPAST * DKV * 4, 0x00020000);
        const __amdgpu_buffer_rsrc_t vbase = __builtin_amdgcn_make_buffer_rsrc((void*)(cv + (size_t)b * NPAST * DKV), 0, NPAST * DKV * 4, 0x00020000);
        const int lane32 = lane * 32;
        LAS float* SL = (LAS float*)(C.lds + 81920) + wave_o * 1024;
        float mrun = -INFINITY;
        {
            f32x4 kb0[8][2], kb1[8][2];
#define AS_LOAD(buf, base, c) do { _Pragma("unroll") for (int r_ = 0; r_ < 8; ++r_) { const int so_ = (i0 - d * ((c) * 8 + r_)) * (DKV * 4); buf[r_][0] = __builtin_bit_cast(f32x4, __builtin_amdgcn_raw_buffer_load_b128(base, lane32, so_, 0)); buf[r_][1] = __builtin_bit_cast(f32x4, __builtin_amdgcn_raw_buffer_load_b128(base, lane32 + 16, so_, 0)); } } while (0)
#define AS_SCORE(buf, c) do { float mine_ = 0.f; _Pragma("unroll") for (int r_ = 0; r_ < 8; ++r_) { const f32x4 k0_ = buf[r_][0], k1_ = buf[r_][1]; \
                float a_ = (q[0] * k0_.x + q[1] * k0_.y) + (q[2] * k0_.z + q[3] * k0_.w) + (q[4] * k1_.x + q[5] * k1_.y) + (q[6] * k1_.z + q[7] * k1_.w); \
                a_ = sum8(a_); mine_ = sub == r_ ? a_ : mine_; } \
            mine_ = ((c) * 8 + sub) < nvalid ? mine_ : -INFINITY; SL[(c) * 64 + lane] = mine_; mrun = fmaxf(mrun, mine_); } while (0)
            AS_LOAD(kb0, kbase, 0);
#pragma unroll 1
            for (int c = 0; c < 16; c += 2) {
                AS_LOAD(kb1, kbase, c + 1); __builtin_amdgcn_sched_barrier(0);
                AS_SCORE(kb0, c); __builtin_amdgcn_sched_barrier(0);
                if (c + 2 < 16) AS_LOAD(kb0, kbase, c + 2);
                __builtin_amdgcn_sched_barrier(0);
                AS_SCORE(kb1, c + 1); __builtin_amdgcn_sched_barrier(0);
            }
        }
        float mx = fmaxf(fmaxf(fmaxf(scn[0], scn[1]), fmaxf(scn[2], scn[3])), max8(mrun));
        float den = 0.f, o[8];
#pragma unroll
        for (int e = 0; e < 8; ++e) o[e] = 0.f;
#pragma unroll
        for (int j = 0; j < 4; ++j) if (j < nn) { const float p = __expf(scn[j] - mx); den += p; const h8 v8 = *(const h8*)(vh + ((size_t)MP + b * 4 + (s - j)) * DKV + lane * 8);
#pragma unroll
            for (int e = 0; e < 8; ++e) o[e] += p * (float)v8[e]; }
        {
            f32x4 vb0[8][2], vb1[8][2];
            const LAS float* SLr = SL + (lane & ~7);
#define AS_PV(buf, c) do { _Pragma("unroll") for (int r_ = 0; r_ < 8; ++r_) { const float w_ = __expf(SLr[(c) * 64 + r_] - mx); den += w_; const f32x4 v0_ = buf[r_][0], v1_ = buf[r_][1]; \
                o[0] += w_ * v0_.x; o[1] += w_ * v0_.y; o[2] += w_ * v0_.z; o[3] += w_ * v0_.w; o[4] += w_ * v1_.x; o[5] += w_ * v1_.y; o[6] += w_ * v1_.z; o[7] += w_ * v1_.w; } } while (0)
            AS_LOAD(vb0, vbase, 0);
#pragma unroll 1
            for (int c = 0; c < 16; c += 2) {
                AS_LOAD(vb1, vbase, c + 1); __builtin_amdgcn_sched_barrier(0);
                AS_PV(vb0, c); __builtin_amdgcn_sched_barrier(0);
                if (c + 2 < 16) AS_LOAD(vb0, vbase, c + 2);
                __builtin_amdgcn_sched_barrier(0);
                AS_PV(vb1, c + 1); __builtin_amdgcn_sched_barrier(0);
            }
#undef AS_LOAD
#undef AS_SCORE
#undef AS_PV
        }
        const float inv = 1.0f / den;
        h8 r8;
#pragma unroll
        for (int e = 0; e < 8; ++e) r8[e] = (f16)(o[e] * inv);
        *(h8*)(og + ((size_t)g * M + qrow) * DKV + hh * 64 + sub * 8) = r8;
        if (sub == 0) lse[((size_t)g * M + qrow) * NH + hh] = mx + __logf(den);
    }
}

constexpr int NPHASE = 43;
__host__ __device__ constexpr bool phase_exists(int k) {
    if (k == 0) return true;
    const int L = (k - 1) / 11, p = (k - 1) % 11;
    if (p == 7 || p == 10) return false;
    if (L < 2) { if (p == 1 || p == 3) return false; if (p <= 8) return true; return L == 1; }
    if (p == 3 || p == 4 || p == 5) return false;
    if (p <= 8) return true;
    return L == 2;
}
#ifndef PHASE_MASK
#define PHASE_MASK 0xFFFFFFFFu
#endif
#define PHM(b) ((PHASE_MASK >> (b)) & 1u)
#define REPS(b) (((REP_MASK >> (b)) & 1u) ? REP_N : 0)
#define IN(k) (lo <= (k) && (k) < hi && fresh(C))
#define SEAM(k) do { if (multi && (k) + 1 < hi) xcd_barrier(bar); } while (0)
template <int L>
__device__ __forceinline__ void layer_body(Ctx& C, const int lo, const int hi, const bool multi, const XcdBarrier& bar) {
        const int pb = 1 + 11 * L;
        if (L < 2) {
            if (PHM(1) && IN(pb + 0)) {
                for (int rep = 0; rep <= REPS(1); ++rep) {
                    { EpiGateGelu eg{WSP(float, WS_SS), nullptr, WSP(f16, WS_GG)}; Pg8Epi<EpiGateGelu> pe{eg};
                      pg8::Gemm g{WSP(f16, WS_XH), WSP(f16, WS_WIN) + (size_t)L * 2048 * D, D, D, MP, 1024, D, 0, C.wave}; pg8::StaticOrder S; S.init(MP, 1024, C.G, C.bid);
                      pg8::gemm_phase<Pg8Epi<EpiGateGelu>>(C.lds, g, S, pe); }
                                        MiniInConv me{WSP(float, WS_SS), INP(9) + (size_t)L * 4 * D, INP(10) + (size_t)L * D, INP(5) + (size_t)L * BS * 3 * D, WSP(f16, WS_GG), WSP(f16, WS_XC), OUTP + O_SCONV + (size_t)L * BS * 3 * D}; MiniPre<D> pre; pre.valid = false; MiniPost<MiniInConv, D> post{&C, WSP(f16, WS_XH), D, WSP(f16, WS_WIN) + (size_t)L * 2048 * D, D, &me, &pre};
                    { EpiInConv e{WSP(float, WS_SS), INP(9) + (size_t)L * 4 * D, INP(10) + (size_t)L * D, WSP(f16, WS_XC), WSP(float, WS_SIDEAF), WSP(float, WS_SIDEAL), OUTP + O_PCONV + (size_t)L * BP * 3 * D, (LAS float*)(C.lds + HALO_OFF)};
                      pg8::Gemm g{WSP(f16, WS_XH), WSP(f16, WS_WIN) + (size_t)L * 2048 * D + (size_t)1024 * D, D, D, MP, 1024, D, 0, C.wave}; pg8::StaticOrder S; S.init(MP, 1024, C.G, C.bid);
                      pg8::gemm_phase<EpiInConv>(C.lds, g, S, e); }
                    VM_WAIT(); __syncthreads();

                    warm_panel(C, WSP(f16, WS_WG) + (size_t)L * 2048 * 256, (size_t)2048 * 256 * 2);
                    mini_gemm64<MiniInConv, D>(C, WSP(f16, WS_XH), D, WSP(f16, WS_WIN) + (size_t)L * 2048 * D, D, me);
                }
                SEAM(pb + 0); }
            if (PHM(3) && IN(pb + 2)) {
                for (int rep = 0; rep <= REPS(3); ++rep) {
                    EpiScan e{INP(12) + (size_t)L * D, INP(14) + (size_t)L * D, WSP(float, WS_SPL) + (size_t)L * D, WSP(f16, WS_XC), WSP(f16, WS_LA), WSP(f16, WS_IX), WSP(float, WS_CA), WSP(float, WS_CH), (LAS float*)(C.lds + HALO_OFF)};
                    pg8::Gemm g{WSP(f16, WS_XC), WSP(f16, WS_WG) + (size_t)L * 2048 * 256, D, 256, MP, 2048, 256, 512, C.wave}; pg8::StaticOrder S; S.init(MP, 2048, C.G, C.bid);
                    { pg8::Unit uf; for (int i = 0; S.next(i, uf); ++i) g2_fixup(C, L, uf.pm, uf.pn >> 1); VM_WAIT(); __syncthreads(); }
                    MiniScan me{nullptr, INP(12) + (size_t)L * D, INP(14) + (size_t)L * D, WSP(float, WS_SPL) + (size_t)L * D, WSP(f16, WS_XC), WSP(f16, WS_GG), INP(4) + (size_t)L * BS * D, WSP(f16, WS_Y), OUTP + O_SH + (size_t)L * BS * D};
                    MiniPre<256> pre; pre.valid = false; MiniPost<MiniScan, 256> post{&C, WSP(f16, WS_XC), D, WSP(f16, WS_WG) + (size_t)L * 2048 * 256, 256, &me, &pre};
                    pg8::gemm_phase<EpiScan>(C.lds, g, S, e);
                    VM_WAIT(); __syncthreads();
                    mini_gemm64<MiniScan, 256>(C, WSP(f16, WS_XC), D, WSP(f16, WS_WG) + (size_t)L * 2048 * 256, 256, me);
                }
                SEAM(pb + 2); }
            if (PHM(5) && IN(pb + 4)) { warm_panel(C, WSP(f16, WS_WOUT) + (size_t)L * D * D, (size_t)D * D * 2); for (int rep = 0; rep <= REPS(5); ++rep) y_apply(C, L); SEAM(pb + 4); }
            if (PHM(6) && IN(pb + 5)) {
                EpiRes e{nullptr, WSP(float, WS_SS), nullptr, nullptr, nullptr, WSP(f16, WS_XH)};
                EpiRes ed = e; ed.ss_out = WSP(float, WS_DUMS); ed.xout = WSP(float, WS_DUMX);
                for (int rep = REPS(6); rep >= 0; --rep) gemm_both<EpiRes, D>(C, WSP(f16, WS_Y), D, WSP(f16, WS_WOUT) + (size_t)L * D * D, D, D, 0, rep == 0 ? e : ed, ed, WSP(f16, WS_WUP) + (size_t)L * 6144 * D, (size_t)6144 * D * 2);
                SEAM(pb + 5); }
        } else {
            if (IN(pb + 0)) {
                if ((C.G & 15) == 0) {
                    constexpr int NU = BP * NH * 48;
                    const int per = C.G >> 3, half = C.G >> 1, x = C.bid & 7, j = C.bid >> 3, rk = (x >> 1) * per + j, ecut = 5 * half;
                    if (x & 1) { att_sample(C); att_prompt(C, ecut + rk, half, NU); }
                    else { att_prompt(C, rk, half, ecut); att_sample(C); }
                } else {
                    const int vb0 = (C.G & 7) == 0 ? (C.bid & 7) * (C.G >> 3) + (C.bid >> 3) : C.bid;
                    if (C.bid & 1) att_sample(C);
                    att_prompt(C, vb0, C.G, BP * NH * 48);
                    if (!(C.bid & 1)) att_sample(C);
                }
                SEAM(pb + 0); }
            if (PHM(8) && IN(pb + 1)) { warm_panel(C, WSP(f16, WS_WO) + (size_t)(L - 2) * D * 512, (size_t)D * 512 * 2); for (int rep = 0; rep <= REPS(8); ++rep) e5_merge(C); SEAM(pb + 1); }
            if (PHM(9) && IN(pb + 2)) {
                EpiRes e{nullptr, WSP(float, WS_SS), nullptr, nullptr, nullptr, WSP(f16, WS_XH)};
                EpiRes ed = e; ed.ss_out = WSP(float, WS_DUMS); ed.xout = WSP(float, WS_DUMX);
                for (int rep = REPS(9); rep >= 0; --rep) gemm_both<EpiRes, 512>(C, WSP(f16, WS_ATT), 512, WSP(f16, WS_WO) + (size_t)(L - 2) * D * 512, 512, D, 0, rep == 0 ? e : ed, ed, WSP(f16, WS_WUP) + (size_t)L * 6144 * D, (size_t)6144 * D * 2);
                SEAM(pb + 2); }
        }
        if (PHM(10) && IN(pb + 6)) {
            for (int rep = 0; rep <= REPS(10); ++rep) {
                EpiGeglu e{WSP(float, WS_SS), INP(26) + (size_t)L * 3 * DFF, INP(27) + (size_t)L * DFF, WSP(f16, WS_MID), WSP(float, WS_SIDEF), WSP(float, WS_SIDEL), OUTP + O_PFFN + (size_t)L * BP * 2 * DFF, (LAS float*)(C.lds + HALO_OFF)};
                pg8::Gemm g{WSP(f16, WS_XH), WSP(f16, WS_WUP) + (size_t)L * 6144 * D, D, D, MP, 6144, D, 0, C.wave}; pg8::StaticOrder S; S.init(MP, 6144, C.G, C.bid); S.dup = (REP_MASK >> 22) & 1;
                MiniGeglu me{WSP(float, WS_SS), INP(26) + (size_t)L * 3 * DFF, INP(27) + (size_t)L * DFF, INP(6) + (size_t)L * BS * 2 * DFF, WSP(f16, WS_MID), OUTP + O_SFFN + (size_t)L * BS * 2 * DFF};
                MiniPre<D> pre; pre.valid = false; MiniPost<MiniGeglu, D> post{&C, WSP(f16, WS_XH), D, WSP(f16, WS_WUP) + (size_t)L * 6144 * D, D, &me, &pre};
                pg8::gemm_phase<EpiGeglu>(C.lds, g, S, e);
                VM_WAIT(); __syncthreads();

                warm_panel(C, WSP(f16, WS_WDN) + (size_t)L * D * DFF, (size_t)D * DFF * 2);
                mini_gemm64<MiniGeglu, D>(C, WSP(f16, WS_XH), D, WSP(f16, WS_WUP) + (size_t)L * 6144 * D, D, me);
            }
            SEAM(pb + 6); }
        if (PHM(12) && IN(pb + 8)) {
            EpiRes e{nullptr, WSP(float, WS_SS), nullptr, nullptr, L == 3 ? OUTP : nullptr, WSP(f16, WS_XH)};
            EpiRes ed = e; ed.ss_out = WSP(float, WS_DUMS); ed.xout = WSP(float, WS_DUMX);
            { pg8::StaticOrder S0; S0.init(MP, D, C.G, C.bid); pg8::Unit u0; if (S0.next(0, u0)) g5_fixup(C, L, u0.pm); }
            for (int rep = REPS(12); rep >= 0; --rep) gemm_both<EpiRes, DFF>(C, WSP(f16, WS_MID), DFF, WSP(f16, WS_WDN) + (size_t)L * D * DFF, DFF, D, 0, rep == 0 ? e : ed, ed,
                    L == 0 ? (const void*)(WSP(f16, WS_WIN) + (size_t)2048 * D) : (L == 1 ? (const void*)WSP(f16, WS_WKVQ) : (L == 2 ? (const void*)WSP(f16, WS_WQ1) : nullptr)), L == 0 ? (size_t)2048 * D * 2 : (L == 1 ? (size_t)2560 * D * 2 : (L == 2 ? (size_t)1536 * D * 2 : 0)));
            SEAM(pb + 8); }
        if (L == 1 || L == 2) {
            if (PHM(13) && IN(pb + 9)) {
                for (int rep = 0; rep <= REPS(13); ++rep) {
                    const int mode = L == 1 ? 0 : 1, N = L == 1 ? 2560 : 1536; const f16* Wt = L == 1 ? WSP(f16, WS_WKVQ) : WSP(f16, WS_WQ1);
                    EpiKVQ e{WSP(float, WS_SS), WSP(float, WS_ROPE), INP(19), INP(22) + (size_t)mode * HD, WSP(f16, WS_KH), WSP(f16, WS_VH), WSP(f16, WS_QH), OUTP, mode};
                    pg8::Gemm g{WSP(f16, WS_XH), Wt, D, D, M, N, D, 0, C.wave}; pg8::StaticOrder S; S.init(M, N, C.G, C.bid);
                    pg8::gemm_phase<EpiKVQ>(C.lds, g, S, e);
                    if (rep == 0) {
                        const int nwg = (M / 256) * (N / 256), nfull = nwg / C.G, busy = nwg - nfull * C.G;
                        if (C.bid >= busy) { VM_WAIT(); __syncthreads(); convert_weights(C, L == 1 ? 1 : 2, L == 1 ? CV_B : CV_C, C.bid - busy, C.G - busy); }
                    }
                }
                SEAM(pb + 9); }
        }
}
__global__ void __launch_bounds__(NWAVES * 64, 2) fwd_kernel(Args args) {
    extern __shared__ __attribute__((aligned(16))) unsigned char lds_raw[];
    Ctx C;
    C.lds = (LAS unsigned char*)lds_raw;
    C.G = gridDim.x; C.bid = blockIdx.x; C.wave = __builtin_amdgcn_readfirstlane((int)threadIdx.x >> 6);
    C.in = args.in; C.out = (GAS float*)args.out; C.ws = (GAS unsigned char*)args.ws;
    volatile LAS unsigned* MISC = (volatile LAS unsigned*)(C.lds + MISC_OFF);
    for (int u = threadIdx.x; u < (LDS_BYTES - LDSCTL_OFF) / 4; u += NWAVES * 64) ((LAS unsigned*)(C.lds + LDSCTL_OFF))[u] = 0u;
    __syncthreads();
    const int lo = args.ph_lo, hi = args.ph_hi;
    const bool multi = (hi - lo) > 1;
    XcdBarrier bar; bar.bar = (unsigned*)(GAS unsigned*)(C.ws + WS_CTL) + CW_BAR; bar.x = 0; bar.st = nullptr; bar.w0 = C.wave == 0;
    if (multi) bar = xcd_barrier_post((unsigned*)(GAS unsigned*)(C.ws + WS_CTL) + CW_BAR, MISC + 8, C.wave == 0);

    if (PHM(0) && IN(0)) { for (int rep = 0; rep <= REPS(0); ++rep) p0_prologue(C); SEAM(0); }

    layer_body<0>(C, lo, hi, multi, bar); layer_body<1>(C, lo, hi, multi, bar); layer_body<2>(C, lo, hi, multi, bar); layer_body<3>(C, lo, hi, multi, bar);
#undef IN
#undef SEAM
}

#ifndef N_LAUNCH_MODE
#define N_LAUNCH_MODE 1
#endif
extern "C" void kernel_launch(void* const* d_in, const int* in_sizes, int n_in, void* d_out, int out_size, void* d_ws, size_t ws_size, hipStream_t stream) {
    static int grid = 0;
    if (grid == 0) {
        if (n_in != 29 || ws_size < WS_END) { fprintf(stderr, "kernel_launch: unexpected n_in %d or ws %zu (< %zu)\n", n_in, ws_size, (size_t)WS_END); grid = -1; return; }
        int dev = 0, cus = 0, per_cu = 0;
        if (hipGetDevice(&dev) != hipSuccess || hipDeviceGetAttribute(&cus, hipDeviceAttributeMultiprocessorCount, dev) != hipSuccess) { grid = -1; return; }
        if (hipFuncSetAttribute((const void*)fwd_kernel, hipFuncAttributeMaxDynamicSharedMemorySize, LDS_BYTES) != hipSuccess) { fprintf(stderr, "kernel_launch: hipFuncSetAttribute failed\n"); grid = -1; return; }
        if (hipOccupancyMaxActiveBlocksPerMultiprocessor(&per_cu, (const void*)fwd_kernel, NWAVES * 64, LDS_BYTES) != hipSuccess || per_cu < 1) fprintf(stderr, "kernel_launch: occupancy query says %d\n", per_cu);
        (void)hipGetLastError();
        grid = cus;
    }
    if (grid < 0) return;
    (void)hipMemsetAsync((char*)d_ws + WS_CTL, 0, CTL_ZERO_BYTES, stream);
    Args a{};
    for (int i = 0; i < 29; ++i) a.in[i] = (const float*)d_in[i];
    a.out = (float*)d_out; a.ws = (unsigned char*)d_ws;
#if N_LAUNCH_MODE == 1
    a.ph_lo = 0; a.ph_hi = NPHASE;
    hipLaunchKernelGGL(fwd_kernel, dim3(grid), dim3(NWAVES * 64), LDS_BYTES, stream, a);
#else
    for (int k = 0; k < NPHASE; ++k) {
        if (!phase_exists(k)) continue;
        a.ph_lo = k; a.ph_hi = k + 1;
        hipLaunchKernelGGL(fwd_kernel, dim3(grid), dim3(NWAVES * 64), LDS_BYTES, stream, a);
    }
#endif
}
```
